# Optimizing an MI355X kernel written in HIP

```python
import jax, jax.numpy as jnp
from jax import lax
import numpy as np

D_MODEL = 1024
BATCH = 8
SEQ = 2048
DEPTH = 4

CTX_LEN = 256
GRID_W = 64
RET_HEADS = 8
RET_DK = 64
RET_DV = 128
RET_QK = RET_HEADS * RET_DK
RET_V = RET_HEADS * RET_DV
RET_CHUNK = 128
ROPE_BASE = 10000.0
LRU_W = D_MODEL
LRU_BLOCKS = 16
LRU_BW = LRU_W // LRU_BLOCKS
LRU_C = 8.0
CONV_W = 4
CONV_LEFT = 2
FFN_HIDDEN = 2816
FFN_RES = 0.5
N_MOD = 9
EPS = 1e-6
PROJ_SIZES = (RET_QK, RET_QK, RET_V, RET_V, LRU_W, LRU_W, D_MODEL, D_MODEL)
PROJ_W = 2 * RET_QK + 2 * RET_V + 2 * LRU_W + 2 * D_MODEL

kernel_name = "hybrid_retention_rglru_prefix_dit"


def rms_norm(x, g):
    xf = x.astype(jnp.float32)
    y = xf * lax.rsqrt(jnp.mean(xf * xf, axis=-1, keepdims=True) + EPS)
    return (y * g.astype(jnp.float32)).astype(x.dtype)


def ada_norm(x, g, shift, scale):
    return rms_norm(x, g) * (1 + scale) + shift


def ffn_sublayer(x, mod, g, w_gu, w_down):
    shift, scale, gate = mod
    h = ada_norm(x, g, shift, scale)
    u, v = jnp.split(h @ w_gu, 2, axis=-1)
    return x + FFN_RES * gate * ((jax.nn.silu(u) * v) @ w_down)


def split_proj(z):
    out, start = [], 0
    for size in PROJ_SIZES:
        out.append(z[..., start:start + size])
        start += size
    return out


def grid_rotary(rows):
    row = jnp.repeat(jnp.arange(rows, dtype=jnp.float32), GRID_W)
    col = jnp.tile(jnp.arange(GRID_W, dtype=jnp.float32), rows)
    n_f = RET_DK // 4
    inv = ROPE_BASE ** (-jnp.arange(n_f, dtype=jnp.float32) / n_f)
    ang = jnp.concatenate([row[:, None] * inv, col[:, None] * inv], axis=-1)
    return jnp.cos(ang), jnp.sin(ang)


def apply_rotary(a, cos, sin):
    a1, a2 = jnp.split(a, 2, axis=-1)
    cs, sn = cos[None, :, None, :], sin[None, :, None, :]
    return jnp.concatenate([a1 * cs - a2 * sn, a1 * sn + a2 * cs], axis=-1)


def retention_heads(z, cos, sin):
    bsz, t = z[0].shape[:2]
    q = z[0].reshape(bsz, t, RET_HEADS, RET_DK).astype(jnp.float32)
    k = z[1].reshape(bsz, t, RET_HEADS, RET_DK).astype(jnp.float32)
    v = z[2].reshape(bsz, t, RET_HEADS, RET_DV).astype(jnp.float32)
    if cos is not None:
        q = apply_rotary(q, cos, sin)
        k = apply_rotary(k, cos, sin)
    return q, k * (RET_DK ** -0.5), v


def retention_chunkwise(q, k, v, log_g, s0, include_diag):
    bsz, t, nh, _ = q.shape
    n = t // RET_CHUNK

    def to_chunks(a):
        return a.reshape(bsz, n, RET_CHUNK, nh, a.shape[-1]).transpose(1, 0, 3, 2, 4)

    idx = jnp.arange(RET_CHUNK, dtype=jnp.float32)
    rel = idx[:, None] - idx[None, :]
    mask = (rel >= 0) if include_diag else (rel > 0)
    lg = log_g[:, None, None]
    d_intra = jnp.where(mask[None], jnp.exp(lg * jnp.maximum(rel, 0.0)[None]), 0.0)
    q_dec = jnp.exp(log_g[:, None] * (idx + 1.0))[None, :, :, None]
    k_dec = jnp.exp(log_g[:, None] * (RET_CHUNK - 1.0 - idx))[None, :, :, None]
    c_dec = jnp.exp(log_g * RET_CHUNK)[None, :, None, None]

    def step(s, blk):
        qc, kc, vc = blk
        scores = jnp.einsum('bhid,bhjd->bhij', qc, kc) * d_intra
        o = (jnp.einsum('bhij,bhjv->bhiv', scores, vc)
             + jnp.einsum('bhid,bhdv->bhiv', qc * q_dec, s))
        s = s * c_dec + jnp.einsum('bhjd,bhjv->bhdv', kc * k_dec, vc)
        return s, o

    s, o = lax.scan(step, s0, (to_chunks(q), to_chunks(k), to_chunks(v)))
    o = o.transpose(1, 0, 3, 2, 4).reshape(bsz, t, nh, v.shape[-1])
    return o, s


def head_norm(o):
    mu = jnp.mean(o, axis=-1, keepdims=True)
    var = jnp.mean(jnp.square(o - mu), axis=-1, keepdims=True)
    return (o - mu) * lax.rsqrt(var + EPS)


def short_conv(u, w, b):
    t = u.shape[1]
    up = jnp.pad(u, ((0, 0), (CONV_LEFT, CONV_W - 1 - CONV_LEFT), (0, 0)))
    out = up[:, 0:t] * w[0]
    for j in range(1, CONV_W):
        out = out + up[:, j:j + t] * w[j]
    return out + b


def _lin_comb(l, r):
    return (l[0] * r[0], r[0] * l[1] + r[1])


def rg_lru_dir(u, wg, bg, lam, h0, reverse):
    if reverse:
        u = u[:, ::-1]
    bsz, t, w = u.shape
    g = jnp.einsum('btnk,gnkj->gbtnj', u.reshape(bsz, t, LRU_BLOCKS, LRU_BW),
                   wg.astype(jnp.float32)).reshape(2, bsz, t, w)
    g = g + bg.astype(jnp.float32)[:, None, None, :]
    r = jax.nn.sigmoid(g[0])
    i = jax.nn.sigmoid(g[1])
    log_a = -LRU_C * r * jax.nn.softplus(-lam.astype(jnp.float32))
    a = jnp.exp(log_a)
    b = jnp.sqrt(-jnp.expm1(2.0 * log_a)) * (i * u)
    a_cum, b_cum = lax.associative_scan(_lin_comb, (a, b), axis=1)
    h = a_cum * h0[:, None, :] + b_cum
    h_last = h[:, -1]
    if reverse:
        h = h[:, ::-1]
    return h, h_last


def merge_branches(z, o_ret, h_lru, w_ret_o, w_lru_o, w_out):
    g_ret, g_lru, gate_a, gate_b = z[3], z[5], z[6], z[7]
    bsz, t = o_ret.shape[:2]
    dt = g_ret.dtype
    o = head_norm(o_ret).reshape(bsz, t, RET_V).astype(dt)
    y_a = (o * jax.nn.silu(g_ret)) @ w_ret_o
    y_b = (h_lru.astype(dt) * jax.nn.gelu(g_lru)) @ w_lru_o
    return (jax.nn.sigmoid(gate_a) * y_a + jax.nn.sigmoid(gate_b) * y_b) @ w_out


def token_mixer(hc, hx, cos, sin, w_in, ret_logit, w_ret_o, conv_w, conv_b,
                gate_w, gate_b, lam, w_lru_o, w_out, with_ctx_out):
    zc = split_proj(hc @ w_in)
    zx = split_proj(hx @ w_in)
    bsz = hc.shape[0]
    log_g = jax.nn.log_sigmoid(ret_logit.astype(jnp.float32))

    qc, kc, vc = retention_heads(zc, None, None)
    qx, kx, vx = retention_heads(zx, cos, sin)
    s_init = jnp.zeros((bsz, RET_HEADS, RET_DK, RET_DV), jnp.float32)
    oc_f, s_f = retention_chunkwise(qc, kc, vc, log_g[0], s_init, True)
    oc_b, s_b = retention_chunkwise(qc[:, ::-1], kc[:, ::-1], vc[:, ::-1], log_g[1], s_init, False)
    ox_f, _ = retention_chunkwise(qx, kx, vx, log_g[0], s_f, True)
    ox_b, _ = retention_chunkwise(qx[:, ::-1], kx[:, ::-1], vx[:, ::-1], log_g[1], s_b, False)
    ox = ox_f + ox_b[:, ::-1]

    uc = short_conv(zc[4], conv_w, conv_b).astype(jnp.float32)
    ux = short_conv(zx[4], conv_w, conv_b).astype(jnp.float32)
    h0 = jnp.zeros((bsz, LRU_W), jnp.float32)
    hc_f, st_f = rg_lru_dir(uc, gate_w[0], gate_b[0], lam[0], h0, False)
    hc_b, st_b = rg_lru_dir(uc, gate_w[1], gate_b[1], lam[1], h0, True)
    hx_f, _ = rg_lru_dir(ux, gate_w[0], gate_b[0], lam[0], st_f, False)
    hx_b, _ = rg_lru_dir(ux, gate_w[1], gate_b[1], lam[1], st_b, True)

    y_x = merge_branches(zx, ox, hx_f + hx_b, w_ret_o, w_lru_o, w_out)
    y_c = None
    if with_ctx_out:
        y_c = merge_branches(zc, oc_f + oc_b[:, ::-1], hc_f + hc_b, w_ret_o, w_lru_o, w_out)
    return y_c, y_x


def setup_inputs(seed: int = 0) -> dict:
    key = jax.random.key(seed)
    ks = jax.random.split(key, 26)
    f32 = jnp.float32
    L, D, F = DEPTH, D_MODEL, FFN_HIDDEN

    def nrm(k, shape, fan_in):
        return jax.random.normal(k, shape, f32) * (fan_in ** -0.5)

    def small(k, shape, s=0.02):
        return s * jax.random.normal(k, shape, f32)

    gamma = 1.0 - 2.0 ** (-5.0 - jnp.arange(RET_HEADS, dtype=f32))
    ret_decay_logit = jnp.log(gamma / (1.0 - gamma)) + small(ks[12], (L, 2, RET_HEADS), 0.05)
    u = jax.random.uniform(ks[18], (L, 2, LRU_W), f32, 0.9, 0.999)
    a = u ** (1.0 / LRU_C)
    lru_lambda = jnp.log(a) - jnp.log1p(-a)

    return {
        "x": jax.random.normal(ks[0], (BATCH, SEQ, D), f32),
        "c": jax.random.normal(ks[1], (BATCH, D), f32),
        "ctx": jax.random.normal(ks[2], (BATCH, CTX_LEN, D), f32),
        "c_ctx": jax.random.normal(ks[3], (D,), f32),
        "w_mod": nrm(ks[4], (L, D, N_MOD * D), D),
        "b_mod": small(ks[5], (L, N_MOD * D)),
        "norm_g": 1.0 + small(ks[6], (L, 3, D)),
        "ffn1_w_gu": nrm(ks[7], (L, D, 2 * F), D),
        "ffn1_w_down": nrm(ks[8], (L, F, D), F),
        "ffn2_w_gu": nrm(ks[9], (L, D, 2 * F), D),
        "ffn2_w_down": nrm(ks[10], (L, F, D), F),
        "w_in": nrm(ks[11], (L, D, PROJ_W), D),
        "ret_decay_logit": ret_decay_logit,
        "w_ret_o": nrm(ks[13], (L, RET_V, D), RET_V),
        "lru_conv_w": nrm(ks[14], (L, CONV_W, LRU_W), CONV_W),
        "lru_conv_b": small(ks[15], (L, LRU_W)),
        "lru_gate_w": nrm(ks[16], (L, 2, 2, LRU_BLOCKS, LRU_BW, LRU_BW), LRU_BW),
        "lru_gate_b": small(ks[17], (L, 2, 2, LRU_W)),
        "lru_lambda": lru_lambda,
        "w_lru_o": nrm(ks[19], (L, LRU_W, D), LRU_W),
        "w_out": nrm(ks[20], (L, D, D), D),
        "final_g": 1.0 + small(ks[21], (D,)),
    }


def reference(x, c, ctx, c_ctx, w_mod, b_mod, norm_g, ffn1_w_gu, ffn1_w_down,
              ffn2_w_gu, ffn2_w_down, w_in, ret_decay_logit, w_ret_o, lru_conv_w,
              lru_conv_b, lru_gate_w, lru_gate_b, lru_lambda, w_lru_o, w_out, final_g):
    n_lat = x.shape[1]
    rows = n_lat // GRID_W
    cos, sin = grid_rotary(rows)
    for l in range(DEPTH):
        last = l == DEPTH - 1
        m_x = jnp.split((jax.nn.silu(c) @ w_mod[l] + b_mod[l])[:, None, :], N_MOD, axis=-1)
        m_c = jnp.split(jax.nn.silu(c_ctx) @ w_mod[l] + b_mod[l], N_MOD, axis=-1)

        ctx = ffn_sublayer(ctx, m_c[0:3], norm_g[l, 0], ffn1_w_gu[l], ffn1_w_down[l])
        x = ffn_sublayer(x, m_x[0:3], norm_g[l, 0], ffn1_w_gu[l], ffn1_w_down[l])

        hc = ada_norm(ctx, norm_g[l, 1], m_c[3], m_c[4])
        hx = ada_norm(x, norm_g[l, 1], m_x[3], m_x[4])
        y_c, y_x = token_mixer(hc, hx, cos, sin, w_in[l], ret_decay_logit[l], w_ret_o[l],
                               lru_conv_w[l], lru_conv_b[l], lru_gate_w[l], lru_gate_b[l],
                               lru_lambda[l], w_lru_o[l], w_out[l], not last)
        x = x + m_x[5] * y_x

        x = ffn_sublayer(x, m_x[6:9], norm_g[l, 2], ffn2_w_gu[l], ffn2_w_down[l])
        if not last:
            ctx = ctx + m_c[5] * y_c
            ctx = ffn_sublayer(ctx, m_c[6:9], norm_g[l, 2], ffn2_w_gu[l], ffn2_w_down[l])
    return rms_norm(x, final_g)
```

```cpp
#include <hip/hip_runtime.h>
#include <hip/hip_cooperative_groups.h>
#include <cstdio>
#include <cstdint>
namespace cg = cooperative_groups;

#ifndef PROBE_K
#define PROBE_K -1
#endif
#ifndef PROBE_N
#define PROBE_N 1
#endif
#ifndef MK_MULTI
#define MK_MULTI 0
#endif

#define LAS __attribute__((address_space(3)))
#define GAS __attribute__((address_space(1)))
typedef unsigned short bf16_t;
typedef short bf16x8 __attribute__((ext_vector_type(8)));
typedef float f32x4 __attribute__((ext_vector_type(4)));
typedef unsigned u32x4 __attribute__((ext_vector_type(4)));
typedef unsigned u32x2 __attribute__((ext_vector_type(2)));

constexpr int D = 1024, NB = 8, SEQ = 2048, CTXL = 256, TB = 2304, MROWS = NB * TB, NL = 4, FH = 2816, PW = 7168;
constexpr int NH = 8, DK = 64, DV = 128, NCH = 18, NMOD = 9 * D;
constexpr float EPS = 1e-6f;
constexpr int NTHREADS = 512;
constexpr int LDS_WORK = 131072;
constexpr int LDS_BYTES = LDS_WORK + 1024;

constexpr size_t al256(size_t x) { return (x + 255) & ~(size_t)255; }
constexpr size_t WS_BAR = 0;
constexpr size_t WS_MODS = 16384;
constexpr size_t WS_ROPE = al256(WS_MODS + (size_t)NL * 9 * NMOD * 4);
constexpr size_t WS_WGU1 = al256(WS_ROPE + (size_t)2 * SEQ * 32 * 4);
constexpr size_t WS_WD1 = WS_WGU1 + (size_t)2 * FH * D * 2;
constexpr size_t WS_WGU2 = WS_WD1 + (size_t)FH * D * 2;
constexpr size_t WS_WD2 = WS_WGU2 + (size_t)2 * FH * D * 2;
constexpr size_t WS_WIN = WS_WD2 + (size_t)FH * D * 2;
constexpr size_t WS_WRO = WS_WIN + (size_t)PW * D * 2;
constexpr size_t WS_WLO = WS_WRO + (size_t)D * D * 2;
constexpr size_t WS_WOUT = WS_WLO + (size_t)D * D * 2;
constexpr size_t WS_R = al256(WS_WOUT + (size_t)D * D * 2);
constexpr size_t WS_AN = WS_R + (size_t)MROWS * D * 4;
constexpr size_t WS_ZONE = WS_AN + (size_t)MROWS * D * 2;
constexpr size_t WS_Q = WS_ZONE;
constexpr size_t WS_KN = WS_Q + (size_t)MROWS * 512 * 2;
constexpr size_t WS_KT = WS_KN + (size_t)MROWS * 512 * 2;
constexpr size_t WS_VT = WS_KT + (size_t)MROWS * 512 * 2;
constexpr size_t WS_SG = WS_VT + (size_t)MROWS * D * 2;
constexpr size_t WS_LX = WS_SG + (size_t)MROWS * D * 2;
constexpr size_t WS_GG = WS_LX + (size_t)MROWS * D * 2;
constexpr size_t WS_GA = WS_GG + (size_t)MROWS * D * 2;
constexpr size_t WS_GB = WS_GA + (size_t)MROWS * D * 2;
constexpr size_t WS_ST = WS_GB + (size_t)MROWS * D * 2;
constexpr size_t WS_HF = WS_ST + (size_t)NB * NH * 2 * NCH * DV * DK * 2;
constexpr size_t WS_HB = WS_HF + (size_t)MROWS * D * 2;
constexpr size_t WS_END = WS_HB + (size_t)MROWS * D * 2;
constexpr size_t WS_PART = WS_LX;
constexpr size_t WS_PART2 = WS_ZONE;
constexpr size_t WS_H = WS_ZONE;
constexpr size_t WS_T = WS_ZONE;
static_assert((size_t)MROWS * FH * 2 <= WS_LX - WS_ZONE, "H overlay must not reach the split-K partials");
static_assert((size_t)8 * 2048 * D * 4 <= WS_GA - WS_LX, "partials overlay");
static_assert((size_t)8 * 2048 * D * 4 <= WS_SG - WS_ZONE, "merge partials overlay");
static_assert((size_t)MROWS * D * 4 <= WS_SG - WS_ZONE, "T overlay");

struct Args {
    const float* in[22];
    float* out;
    unsigned char* ws;
    int ph_lo, ph_hi;
    int coop, pad;
};

typedef __bf16 bf16v2_t __attribute__((ext_vector_type(2)));
typedef float f32x2_t __attribute__((ext_vector_type(2)));
__device__ __forceinline__ unsigned pk2(float lo, float hi) { const f32x2_t v = {lo, hi}; const bf16v2_t b = __builtin_convertvector(v, bf16v2_t); return __builtin_bit_cast(unsigned, b); }
__device__ __forceinline__ bf16_t f2bf(float f) { return (bf16_t)(pk2(f, 0.f) & 0xffffu); }
__device__ __forceinline__ float bf2f(bf16_t h) { return __uint_as_float(((unsigned)h) << 16); }
__device__ __forceinline__ float bflo(unsigned u) { return __uint_as_float(u << 16); }
__device__ __forceinline__ float bfhi(unsigned u) { return __uint_as_float(u & 0xffff0000u); }
__device__ __forceinline__ float frcp(float x) { return __builtin_amdgcn_rcpf(x); }
__device__ __forceinline__ float sigmoidf_(float x) { return frcp(1.f + __expf(-x)); }
__device__ __forceinline__ float siluf_(float x) { return x * sigmoidf_(x); }
__device__ __forceinline__ float gelu_tanh_(float x) { const float y = 0.7978845608028654f * (x + 0.044715f * x * x * x); return x * sigmoidf_(2.f * y); }
__device__ __forceinline__ float softplusf_(float x) { return fmaxf(x, 0.f) + log1pf(expf(-fabsf(x))); }
__device__ __forceinline__ float wave_sum(float v) {
#pragma unroll
    for (int o = 1; o < 64; o <<= 1) v += __shfl_xor(v, o);
    return v;
}
__device__ __forceinline__ float sum16(float v) {
#pragma unroll
    for (int o = 1; o < 16; o <<= 1) v += __shfl_xor(v, o);
    return v;
}
__device__ __forceinline__ bf16x8 scale8(bf16x8 f, const float (&s)[8]) {
    u32x4 v = __builtin_bit_cast(u32x4, f);
#pragma unroll
    for (int i = 0; i < 4; ++i) v[i] = pk2(bflo(v[i]) * s[2 * i], bfhi(v[i]) * s[2 * i + 1]);
    return __builtin_bit_cast(bf16x8, v);
}
__device__ __forceinline__ bf16x8 scale1(bf16x8 f, float s) {
    u32x4 v = __builtin_bit_cast(u32x4, f);
#pragma unroll
    for (int i = 0; i < 4; ++i) v[i] = pk2(bflo(v[i]) * s, bfhi(v[i]) * s);
    return __builtin_bit_cast(bf16x8, v);
}

namespace pg8 {
constexpr int BM = 256, BK = 64, HALF = 128, HTB = HALF * BK * 2, NXCD = 8, WGM = 8;
__device__ __forceinline__ int lds_byte(int r, int c) { const int st = (r >> 4) * 2 + (c >> 5), rr = r & 15, cc = c & 31, ob = rr * 64 + cc * 2; return st * 1024 + (ob ^ (((ob >> 9) & 1) << 5)); }
__device__ __forceinline__ void stage_rc(int b, int& R, int& C) { const int st = b / 1024, sb = b % 1024, swz = sb ^ (((sb >> 9) & 1) << 5); R = (st >> 1) * 16 + swz / 64; C = (st & 1) * 32 + (swz % 64) / 2; }

struct Unit { int pm, pn, sub, kt0, nt, sp; };
struct Gemm { const bf16_t* A0; const bf16_t* A1; const bf16_t* B0; const bf16_t* B1; int K; };

struct Sched {
    int nM, nN, G, c, flags, ntK;
    __device__ __forceinline__ void init(int nM_, int nN_, int G_, int c_, int dual_, int latonly_, int tail_, int K_) { nM = tail_ ? 64 : nM_; nN = nN_; G = G_; c = c_; flags = (dual_ ? 1 : 0) | (latonly_ ? 2 : 0) | (tail_ == 1 ? 4 : 0) | (tail_ == 2 ? 8 : 0); ntK = K_ / BK; }
    __device__ __forceinline__ void entry(int i, int& valid, int& pm, int& pn, int& sub, int& kt0, int& nt, int& sp) const {
        const int tidx = (flags & 4) ? 1 : ((flags & 8) ? 2 : 1000);
        const bool tl = i >= tidx;
        const bool tm = (flags & 8) != 0;
        const int tt = c >> 3, spv = c & 7, tpt = ntK >> 1, base = tpt >> 3, rem = tpt & 7;
        const int t_pm = 64 + (tt >> 2), t_pn = tt & 3;
        const int t_kt0 = tm ? 4 * (spv & 3) : 2 * (spv * base + (spv < rem ? spv : rem)), t_nt = tm ? 4 : 2 * (base + (spv < rem ? 1 : 0));
        const int t_sub = tm ? (2 | (spv >> 2)) : 2;
        const int nwg = nM * nN;
        const int ii = (flags & 1) ? (i >> 1) : i;
        const long L = (long)ii * G + c;
        const bool nv = L < nwg;
        int wgid = nv ? (int)L : 0; { const int q = nwg / NXCD, r = nwg % NXCD, xcd = wgid % NXCD, off = wgid / NXCD; wgid = (xcd < r ? xcd * (q + 1) : r * (q + 1) + (xcd - r) * q) + off; }
        const int nig = WGM * nN, gid = wgid / nig, fm = gid * WGM, gsz = (nM - fm) < WGM ? (nM - fm) : WGM;
        int n_pm = fm + ((wgid % nig) % gsz); const int n_pn = (wgid % nig) / gsz;
        if (flags & 2) n_pm = 9 * (n_pm >> 3) + 1 + (n_pm & 7);
        valid = tl ? (i == tidx ? 1 : 0) : (nv ? 1 : 0);
        pm = tl ? t_pm : n_pm; pn = tl ? t_pn : n_pn; sub = tl ? t_sub : ((flags & 1) ? (i & 1) : 0);
        kt0 = tl ? t_kt0 : 0; nt = tl ? t_nt : ntK; sp = tl ? spv : 0;
    }
};

__device__ __forceinline__ bool get_unit(LAS unsigned char* lds, int i, Unit& u) {
    if (i >= 16) return false;
    const LAS int* e = (const LAS int*)(lds + 131072 + 64) + 8 * i;
    const int valid = __builtin_amdgcn_readfirstlane(e[0]);
    u.pm = __builtin_amdgcn_readfirstlane(e[1]); u.pn = __builtin_amdgcn_readfirstlane(e[2]); u.sub = __builtin_amdgcn_readfirstlane(e[3]);
    u.kt0 = __builtin_amdgcn_readfirstlane(e[4]); u.nt = __builtin_amdgcn_readfirstlane(e[5]); u.sp = __builtin_amdgcn_readfirstlane(e[6]);
    return valid != 0;
}
__device__ __forceinline__ void build_units(LAS unsigned char* lds, const Sched& S) {
    const int t = threadIdx.x;
    if (t < 16) {
        int valid, pm, pn, sub, kt0, nt, sp;
        S.entry(t, valid, pm, pn, sub, kt0, nt, sp);
        asm volatile("" : "+v"(kt0), "+v"(nt), "+v"(sp), "+v"(valid));
        LAS int* e = (LAS int*)(lds + 131072 + 64) + 8 * t;
        e[0] = valid; e[1] = pm; e[2] = pn; e[3] = sub; e[4] = kt0; e[5] = nt; e[6] = sp; e[7] = 0;
    }
    __syncthreads();
}

template <class Epi>
__device__ __forceinline__ void gemm_phase(LAS unsigned char* lds, const Gemm g, const Epi& E) {
    int tid = threadIdx.x; asm volatile("" : "+v"(tid));
    const int wid = __builtin_amdgcn_readfirstlane(tid >> 6), lane = tid & 63, wr = wid >> 2, wc = wid & 3, fr = lane & 15, fq = lane >> 4;
    const int K = g.K;
    unsigned voffA[2];
#pragma unroll
    for (int i = 0; i < 2; ++i) { int R, C; stage_rc(tid * 16 + i * 8192, R, C); voffA[i] = (unsigned)(R * K + C) * 2u; }
    const size_t kstep = (size_t)(BK * 2);
    const size_t hstep = (size_t)HALF * K * 2;
    const size_t tstep = 2 * hstep;
    const unsigned ldsw = (unsigned)wid * 1024u;
    const int aoff = lds_byte(wr * 64 + fr, fq * 8), boff = lds_byte(wc * 32 + fr, fq * 8);
#define PG8_SA(b, h) (((b) * 2 + (h)) * HTB)
#define PG8_SB(b, h) ((4 + (b) * 2 + (h)) * HTB)
#define PG8_STAGE(bufoff, gbase, voff) do { _Pragma("unroll") for (int _i = 0; _i < 2; ++_i) \
        __builtin_amdgcn_global_load_lds((const unsigned*)((const char*)(gbase) + (voff)[_i]), (LAS unsigned*)(lds + (bufoff) + ldsw + _i * 8192), 16, 0, 0); } while (0)
#define PG8_LDA(dst, b, h) do { _Pragma("unroll") for (int m = 0; m < 4; ++m) _Pragma("unroll") for (int k = 0; k < 2; ++k) dst[m][k] = *(const LAS bf16x8*)(lds + PG8_SA(b, h) + aoff + m * 2048 + k * 1024); } while (0)
#define PG8_LDB(dst, b, h) do { _Pragma("unroll") for (int n = 0; n < 2; ++n) _Pragma("unroll") for (int k = 0; k < 2; ++k) dst[n][k] = *(const LAS bf16x8*)(lds + PG8_SB(b, h) + boff + n * 2048 + k * 1024); } while (0)
#define PG8_MMA(ai, bj, At, Bt) do { __builtin_amdgcn_s_setprio(1); _Pragma("unroll") for (int m = 0; m < 4; ++m) _Pragma("unroll") for (int n = 0; n < 2; ++n) _Pragma("unroll") for (int k = 0; k < 2; ++k) \
        acc[ai][bj][m][n] = __builtin_amdgcn_mfma_f32_16x16x32_bf16(Bt[n][k], At[m][k], acc[ai][bj][m][n], 0, 0, 0); __builtin_amdgcn_s_setprio(0); } while (0)
#define PG8_WAIT_V(n) asm volatile("s_waitcnt vmcnt(" #n ")" ::: "memory")
#define PG8_WAIT_L(n) asm volatile("s_waitcnt lgkmcnt(" #n ")" ::: "memory")
#define PG8_BAR __builtin_amdgcn_s_barrier()
#define PG8_SCHED __builtin_amdgcn_sched_barrier(0)
    Unit cur; int ui = 0;
    if (!get_unit(lds, 0, cur)) return;
    f32x4 acc[2][2][4][2];
#pragma unroll
    for (int a = 0; a < 2; ++a)
#pragma unroll
        for (int b = 0; b < 2; ++b)
#pragma unroll
            for (int m = 0; m < 4; ++m)
#pragma unroll
                for (int n = 0; n < 2; ++n) acc[a][b][m][n] = (f32x4){0.f, 0.f, 0.f, 0.f};
    bf16x8 At[4][2], B0[2][2], B1[2][2];
    const char* cA = (const char*)((cur.sub & 1) ? g.A1 : g.A0) + (size_t)cur.pm * tstep + (size_t)cur.kt0 * kstep; const char* cB = (const char*)((cur.sub & 1) ? g.B1 : g.B0) + (size_t)cur.pn * tstep + (size_t)cur.kt0 * kstep;
    PG8_STAGE(PG8_SB(0, 0), cB, voffA); PG8_STAGE(PG8_SB(0, 1), cB + hstep, voffA); PG8_STAGE(PG8_SA(0, 0), cA, voffA); PG8_STAGE(PG8_SA(0, 1), cA + hstep, voffA);
    if (wr == 1) PG8_BAR;
    PG8_WAIT_V(2); PG8_BAR;
    PG8_STAGE(PG8_SB(1, 0), cB + kstep, voffA); PG8_STAGE(PG8_SA(1, 0), cA + kstep, voffA); PG8_STAGE(PG8_SB(1, 1), cB + hstep + kstep, voffA);
    PG8_WAIT_V(6); PG8_BAR;
    for (;;) {
        Unit nxt; const bool has_next = get_unit(lds, ui + 1, nxt);
        const char* nA = has_next ? (const char*)((nxt.sub & 1) ? g.A1 : g.A0) + (size_t)nxt.pm * tstep + (size_t)nxt.kt0 * kstep : cA; const char* nB = has_next ? (const char*)((nxt.sub & 1) ? g.B1 : g.B0) + (size_t)nxt.pn * tstep + (size_t)nxt.kt0 * kstep : cB;
        const int nt = cur.nt;
        for (int t = 0; t < nt; t += 2) {
            const bool last = (t == nt - 2);
            const char* a1 = cA + (size_t)(t + 1) * kstep;
            const char* a2 = last ? nA : cA + (size_t)(t + 2) * kstep; const char* b2 = last ? nB : cB + (size_t)(t + 2) * kstep;
            const char* a3 = a2 + kstep; const char* b3 = b2 + kstep;
            PG8_LDB(B0, 0, 0); PG8_LDB(B1, 0, 1); PG8_SCHED; PG8_LDA(At, 0, 0); PG8_STAGE(PG8_SA(1, 1), a1 + hstep, voffA);
            PG8_WAIT_V(8); PG8_WAIT_L(0); PG8_BAR; PG8_MMA(0, 0, At, B0); PG8_MMA(0, 1, At, B1); PG8_BAR; PG8_SCHED;
            PG8_LDA(At, 0, 1); PG8_STAGE(PG8_SB(0, 0), b2, voffA); PG8_STAGE(PG8_SB(0, 1), b2 + hstep, voffA); PG8_STAGE(PG8_SA(0, 0), a2, voffA);
            PG8_WAIT_V(8); PG8_WAIT_L(0); PG8_BAR; PG8_MMA(1, 0, At, B0); PG8_MMA(1, 1, At, B1); PG8_BAR; PG8_SCHED;
            PG8_LDB(B0, 1, 0); PG8_LDB(B1, 1, 1); PG8_SCHED; PG8_LDA(At, 1, 0); PG8_STAGE(PG8_SA(0, 1), a2 + hstep, voffA);
            PG8_WAIT_V(8); PG8_WAIT_L(0); PG8_BAR; PG8_MMA(0, 0, At, B0); PG8_MMA(0, 1, At, B1); PG8_BAR; PG8_SCHED;
            PG8_LDA(At, 1, 1); PG8_STAGE(PG8_SB(1, 0), b3, voffA); PG8_STAGE(PG8_SB(1, 1), b3 + hstep, voffA); PG8_STAGE(PG8_SA(1, 0), a3, voffA);
            PG8_WAIT_V(8); PG8_WAIT_L(0); PG8_BAR; PG8_MMA(1, 0, At, B0); PG8_MMA(1, 1, At, B1); PG8_BAR; PG8_SCHED;
        }
        if (wr == 0) PG8_BAR;
        E(acc, cur, wr, wc, fr, fq);
        if (!has_next) break;
        if (!(Epi::KEEP && cur.sub == 0))
#pragma unroll
        for (int a = 0; a < 2; ++a)
#pragma unroll
            for (int b = 0; b < 2; ++b)
#pragma unroll
                for (int m = 0; m < 4; ++m)
#pragma unroll
                    for (int n = 0; n < 2; ++n) acc[a][b][m][n] = (f32x4){0.f, 0.f, 0.f, 0.f};
        ++ui; get_unit(lds, ui, cur); cA = nA; cB = nB;
        if (wr == 1) PG8_BAR;
    }
    PG8_WAIT_V(0);
    PG8_BAR;
#undef PG8_SA
#undef PG8_SB
#undef PG8_STAGE
#undef PG8_LDA
#undef PG8_LDB
#undef PG8_MMA
#undef PG8_WAIT_V
#undef PG8_WAIT_L
#undef PG8_BAR
#undef PG8_SCHED
}
}

typedef f32x4 AccT[2][2][4][2];

struct EpiRes {
    static constexpr bool KEEP = false;
    unsigned char* ws; int l; int gidx; float fac;
    __device__ __forceinline__ void operator()(const AccT& acc, const pg8::Unit& u, int wr, int wc, int fr_, int fq_) const {
        int fr = fr_, fq = fq_; asm volatile("" : "+v"(fr), "+v"(fq));
        const int b = u.pm / 9, pt = u.pm - 9 * b, mr = pt == 0 ? 8 : b;
        const int row0 = u.pm * 256 + wr * 64 + fr, col0 = u.pn * 256 + wc * 32 + 8 * fq;
        const float* mp = (const float*)(ws + WS_MODS) + ((size_t)(l * 9 + mr) * NMOD + (size_t)gidx * D);
        bf16_t* R = (bf16_t*)(ws + WS_R);
        f32x4 gv[2][2];
#pragma unroll
        for (int bj = 0; bj < 2; ++bj)
#pragma unroll
            for (int n = 0; n < 2; ++n) gv[bj][n] = *(const f32x4*)(mp + col0 + bj * 128 + n * 4) * fac;
        if (u.sub & 2) {
            bf16_t* P = (bf16_t*)(ws + WS_PART) + (size_t)u.sp * (2048 * D);
#pragma unroll
            for (int ai = 0; ai < 2; ++ai)
#pragma unroll
                for (int m = 0; m < 4; ++m) {
                    bf16_t* rowp = P + (size_t)(row0 - 16384 + ai * 128 + m * 16) * D + col0;
#pragma unroll
                    for (int bj = 0; bj < 2; ++bj) {
                        const f32x4 t0 = gv[bj][0] * acc[ai][bj][m][0], t1 = gv[bj][1] * acc[ai][bj][m][1];
                        u32x4 o; o[0] = pk2(t0[0], t0[1]); o[1] = pk2(t0[2], t0[3]); o[2] = pk2(t1[0], t1[1]); o[3] = pk2(t1[2], t1[3]);
                        *(u32x4*)(rowp + bj * 128) = o;
                    }
                }
            return;
        }
#pragma unroll
        for (int ai = 0; ai < 2; ++ai)
#pragma unroll
            for (int m = 0; m < 4; ++m) {
                bf16_t* rowp = R + (size_t)(row0 + ai * 128 + m * 16) * D + col0;
#pragma unroll
                for (int bj = 0; bj < 2; ++bj) {
                    const u32x4 rv = *(const u32x4*)(rowp + bj * 128);
                    f32x4 r0, r1; r0[0] = bflo(rv[0]); r0[1] = bfhi(rv[0]); r0[2] = bflo(rv[1]); r0[3] = bfhi(rv[1]); r1[0] = bflo(rv[2]); r1[1] = bfhi(rv[2]); r1[2] = bflo(rv[3]); r1[3] = bfhi(rv[3]);
                    r0 += gv[bj][0] * acc[ai][bj][m][0]; r1 += gv[bj][1] * acc[ai][bj][m][1];
                    u32x4 o; o[0] = pk2(r0[0], r0[1]); o[1] = pk2(r0[2], r0[3]); o[2] = pk2(r1[0], r1[1]); o[3] = pk2(r1[2], r1[3]);
                    *(u32x4*)(rowp + bj * 128) = o;
                }
            }
    }
};

struct EpiSwiglu {
    static constexpr bool KEEP = false;
    unsigned char* ws;
    __device__ __forceinline__ void operator()(const AccT& acc, const pg8::Unit& u, int wr, int wc, int fr_, int fq_) const {
        int fr = fr_, fq = fq_; asm volatile("" : "+v"(fr), "+v"(fq));
        const int row0 = u.pm * 256 + wr * 64 + fr;
        bf16_t* H = (bf16_t*)(ws + WS_H) + 128 * u.pn + 32 * wc + 8 * fq;
#pragma unroll
        for (int ai = 0; ai < 2; ++ai)
#pragma unroll
            for (int m = 0; m < 4; ++m) {
                const f32x4 u0 = acc[ai][0][m][0], u1 = acc[ai][0][m][1], v0 = acc[ai][1][m][0], v1 = acc[ai][1][m][1];
                u32x4 o;
                o[0] = pk2(siluf_(u0[0]) * v0[0], siluf_(u0[1]) * v0[1]); o[1] = pk2(siluf_(u0[2]) * v0[2], siluf_(u0[3]) * v0[3]);
                o[2] = pk2(siluf_(u1[0]) * v1[0], siluf_(u1[1]) * v1[1]); o[3] = pk2(siluf_(u1[2]) * v1[2], siluf_(u1[3]) * v1[3]);
                *(u32x4*)(H + (size_t)(row0 + ai * 128 + m * 16) * FH) = o;
            }
    }
};

struct EpiWin {
    static constexpr bool KEEP = false;
    unsigned char* ws;
    __device__ __forceinline__ void operator()(const AccT& acc, const pg8::Unit& u, int wr, int wc, int fr_, int fq_) const {
        int fr = fr_, fq = fq_; asm volatile("" : "+v"(fr), "+v"(fq));
        const int b = u.pm / 9, pt = u.pm - 9 * b;
        const int pn = u.pn;
        const float* rope = (const float*)(ws + WS_ROPE);
        bf16_t* const Q = (bf16_t*)(ws + WS_Q); bf16_t* const KN = (bf16_t*)(ws + WS_KN); bf16_t* const KT = (bf16_t*)(ws + WS_KT); bf16_t* const VT = (bf16_t*)(ws + WS_VT);
        const int rl0 = wr * 64 + fr;
        if (pn < 4) {
            const bool isk = pn >= 2;
            const int jj0 = 16 * (wc & 1) + 4 * fq;
#pragma unroll
            for (int ai = 0; ai < 2; ++ai)
#pragma unroll
                for (int m = 0; m < 4; ++m) {
                    const int rl = rl0 + ai * 128 + m * 16;
                    const size_t row = (size_t)u.pm * 256 + rl;
                    f32x4 cs = (f32x4){1.f, 1.f, 1.f, 1.f}, sn = (f32x4){0.f, 0.f, 0.f, 0.f};
                    if (pt != 0) { const int tpos = (pt - 1) * 256 + rl; cs = *(const f32x4*)(rope + (size_t)tpos * 32 + jj0); sn = *(const f32x4*)(rope + (size_t)SEQ * 32 + (size_t)tpos * 32 + jj0); }
#pragma unroll
                    for (int bj = 0; bj < 2; ++bj) {
                        const int hq = 4 * (pn & 1) + 2 * bj + (wc >> 1);
                        const f32x4 a1 = acc[ai][bj][m][0], a2 = acc[ai][bj][m][1];
                        f32x4 o1 = a1 * cs - a2 * sn, o2 = a1 * sn + a2 * cs;
                        if (isk) { o1 *= 0.125f; o2 *= 0.125f; }
                        u32x2 p1, p2; p1.x = pk2(o1[0], o1[1]); p1.y = pk2(o1[2], o1[3]); p2.x = pk2(o2[0], o2[1]); p2.y = pk2(o2[2], o2[3]);
                        bf16_t* dst = (isk ? KN : Q) + row * 512 + hq * 64 + jj0;
                        *(u32x2*)dst = p1; *(u32x2*)(dst + 32) = p2;
                        if (isk) {
                            bf16_t* kt = KT + ((size_t)(b * NH + hq) * DK + jj0) * TB + pt * 256 + rl;
                            kt[0] = (bf16_t)(p1.x & 0xffffu); kt[(size_t)TB] = (bf16_t)(p1.x >> 16); kt[(size_t)2 * TB] = (bf16_t)(p1.y & 0xffffu); kt[(size_t)3 * TB] = (bf16_t)(p1.y >> 16);
                            bf16_t* kt2 = kt + (size_t)32 * TB;
                            kt2[0] = (bf16_t)(p2.x & 0xffffu); kt2[(size_t)TB] = (bf16_t)(p2.x >> 16); kt2[(size_t)2 * TB] = (bf16_t)(p2.y & 0xffffu); kt2[(size_t)3 * TB] = (bf16_t)(p2.y >> 16);
                        }
                    }
                    __builtin_amdgcn_sched_barrier(0);
                }
        } else if (pn < 8) {
#pragma unroll
            for (int ai = 0; ai < 2; ++ai)
#pragma unroll
                for (int m = 0; m < 4; ++m) {
                    const int rl = rl0 + ai * 128 + m * 16;
#pragma unroll
                    for (int bj = 0; bj < 2; ++bj) {
                        const int hv = 2 * (pn - 4) + bj;
#pragma unroll
                        for (int n = 0; n < 2; ++n) {
                            const int dv = 32 * wc + 16 * n + 4 * fq;
                            bf16_t* vt = VT + ((size_t)(b * NH + hv) * DV + dv) * TB + pt * 256 + rl;
                            const f32x4 a = acc[ai][bj][m][n];
                            const unsigned p0 = pk2(a[0], a[1]), p1 = pk2(a[2], a[3]);
                            vt[0] = (bf16_t)(p0 & 0xffffu); vt[(size_t)TB] = (bf16_t)(p0 >> 16); vt[(size_t)2 * TB] = (bf16_t)(p1 & 0xffffu); vt[(size_t)3 * TB] = (bf16_t)(p1 >> 16);
                        }
                        __builtin_amdgcn_sched_barrier(0);
                    }
                }
        } else {
            const int seg = (pn - 8) >> 2;
            bf16_t* base = (bf16_t*)(ws + WS_SG + (size_t)seg * ((size_t)MROWS * D * 2));
            const int cbase = 256 * ((pn - 8) & 3) + wc * 32 + 8 * fq;
#pragma unroll
            for (int ai = 0; ai < 2; ++ai)
#pragma unroll
                for (int m = 0; m < 4; ++m) {
                    const size_t row = (size_t)u.pm * 256 + rl0 + ai * 128 + m * 16;
#pragma unroll
                    for (int bj = 0; bj < 2; ++bj) {
                        f32x4 a0 = acc[ai][bj][m][0], a1 = acc[ai][bj][m][1];
                        if (seg == 0) { a0[0] = siluf_(a0[0]); a0[1] = siluf_(a0[1]); a0[2] = siluf_(a0[2]); a0[3] = siluf_(a0[3]); a1[0] = siluf_(a1[0]); a1[1] = siluf_(a1[1]); a1[2] = siluf_(a1[2]); a1[3] = siluf_(a1[3]); }
                        else if (seg == 2) { a0[0] = gelu_tanh_(a0[0]); a0[1] = gelu_tanh_(a0[1]); a0[2] = gelu_tanh_(a0[2]); a0[3] = gelu_tanh_(a0[3]); a1[0] = gelu_tanh_(a1[0]); a1[1] = gelu_tanh_(a1[1]); a1[2] = gelu_tanh_(a1[2]); a1[3] = gelu_tanh_(a1[3]); }
                        else if (seg >= 3) { a0[0] = sigmoidf_(a0[0]); a0[1] = sigmoidf_(a0[1]); a0[2] = sigmoidf_(a0[2]); a0[3] = sigmoidf_(a0[3]); a1[0] = sigmoidf_(a1[0]); a1[1] = sigmoidf_(a1[1]); a1[2] = sigmoidf_(a1[2]); a1[3] = sigmoidf_(a1[3]); }
                        u32x4 o; o[0] = pk2(a0[0], a0[1]); o[1] = pk2(a0[2], a0[3]); o[2] = pk2(a1[0], a1[1]); o[3] = pk2(a1[2], a1[3]);
                        *(u32x4*)(base + row * D + cbase + bj * 128) = o;
                    }
                }
        }
    }
};

struct EpiMerge {
    static constexpr bool KEEP = true;
    unsigned char* ws;
    __device__ __forceinline__ void operator()(AccT& acc, const pg8::Unit& u, int wr, int wc, int fr_, int fq_) const {
        int fr = fr_, fq = fq_; asm volatile("" : "+v"(fr), "+v"(fq));
        const int row0 = u.pm * 256 + wr * 64 + fr, col0 = u.pn * 256 + wc * 32 + 8 * fq;
        const bf16_t* GA = (const bf16_t*)(ws + WS_GA); const bf16_t* GB = (const bf16_t*)(ws + WS_GB);
        bf16_t* MB = (bf16_t*)(ws + WS_SG);
        if (u.sub & 2) {
            const bf16_t* G = (u.sub & 1) ? GB : GA;
            float* P = (float*)(ws + WS_PART2) + (size_t)u.sp * (2048 * D);
#pragma unroll
            for (int ai = 0; ai < 2; ++ai)
#pragma unroll
                for (int m = 0; m < 4; ++m) {
                    const size_t ro = (size_t)(row0 + ai * 128 + m * 16) * D + col0;
                    const size_t po = (size_t)(row0 - 16384 + ai * 128 + m * 16) * D + col0;
#pragma unroll
                    for (int bj = 0; bj < 2; ++bj) {
                        const u32x4 gv = *(const u32x4*)(G + ro + bj * 128);
                        f32x4 s0, s1; s0[0] = bflo(gv[0]); s0[1] = bfhi(gv[0]); s0[2] = bflo(gv[1]); s0[3] = bfhi(gv[1]); s1[0] = bflo(gv[2]); s1[1] = bfhi(gv[2]); s1[2] = bflo(gv[3]); s1[3] = bfhi(gv[3]);
                        *(f32x4*)(P + po + bj * 128) = s0 * acc[ai][bj][m][0];
                        *(f32x4*)(P + po + bj * 128 + 4) = s1 * acc[ai][bj][m][1];
                    }
                }
            return;
        }
#pragma unroll
        for (int ai = 0; ai < 2; ++ai)
#pragma unroll
            for (int m = 0; m < 4; ++m) {
                const size_t ro = (size_t)(row0 + ai * 128 + m * 16) * D + col0;
#pragma unroll
                for (int bj = 0; bj < 2; ++bj) {
                    const size_t o = ro + bj * 128;
                    const u32x4 gb = *(const u32x4*)(GB + o);
                    f32x4 b0, b1;
                    b0[0] = fmaxf(bflo(gb[0]), 1e-6f); b0[1] = fmaxf(bfhi(gb[0]), 1e-6f); b0[2] = fmaxf(bflo(gb[1]), 1e-6f); b0[3] = fmaxf(bfhi(gb[1]), 1e-6f);
                    b1[0] = fmaxf(bflo(gb[2]), 1e-6f); b1[1] = fmaxf(bfhi(gb[2]), 1e-6f); b1[2] = fmaxf(bflo(gb[3]), 1e-6f); b1[3] = fmaxf(bfhi(gb[3]), 1e-6f);
                    if ((u.sub & 1) == 0) {
                        const u32x4 ga = *(const u32x4*)(GA + o);
                        f32x4 a0, a1; a0[0] = bflo(ga[0]); a0[1] = bfhi(ga[0]); a0[2] = bflo(ga[1]); a0[3] = bfhi(ga[1]); a1[0] = bflo(ga[2]); a1[1] = bfhi(ga[2]); a1[2] = bflo(ga[3]); a1[3] = bfhi(ga[3]);
#pragma unroll
                        for (int j = 0; j < 4; ++j) { acc[ai][bj][m][0][j] *= a0[j] * frcp(b0[j]); acc[ai][bj][m][1][j] *= a1[j] * frcp(b1[j]); }
                    } else {
                        const f32x4 t0 = b0 * acc[ai][bj][m][0], t1 = b1 * acc[ai][bj][m][1];
                        u32x4 w; w[0] = pk2(t0[0], t0[1]); w[1] = pk2(t0[2], t0[3]); w[2] = pk2(t1[0], t1[1]); w[3] = pk2(t1[2], t1[3]);
                        *(u32x4*)(MB + o) = w;
                    }
                }
            }
    }
};

#define XB_TMO      128
#define XB_XCNT(j)  (256  + 64 * (j))
#define XB_XSUB(j)  (1280 + 64 * (j))
#define XB_XGEN(j)  (2304 + 64 * (j))
#define XB_TOP      3328
#define XB_TOPGEN   3392
#define XCD_BAR_WORDS 3456
#define XB_SPIN_CAP (1u << 18)

__device__ __forceinline__ unsigned xb_ld(unsigned* p)              { return __hip_atomic_load(p, __ATOMIC_RELAXED, __HIP_MEMORY_SCOPE_AGENT); }
__device__ __forceinline__ unsigned xb_add(unsigned* p, unsigned v) { return __hip_atomic_fetch_add(p, v, __ATOMIC_RELAXED, __HIP_MEMORY_SCOPE_AGENT); }
__device__ __forceinline__ unsigned xb_xcc_id() { return (unsigned)__builtin_amdgcn_s_getreg((3 << 11) | 20) & 0xFu; }
#define XB_SPIN(cond, bar) do { unsigned _sp = 0; while (cond) { __builtin_amdgcn_s_sleep(1); \
    if ((++_sp & 255u) == 0u) { if (xb_ld(&(bar)[XB_TMO])) break; if (_sp > XB_SPIN_CAP) { atomicAdd(&(bar)[XB_TMO], 1u); break; } } } } while (0)

struct XcdBarrier {
    unsigned* bar; unsigned x;
    volatile LAS unsigned* st;
};

__device__ __forceinline__ XcdBarrier xcd_barrier_post(unsigned* bar, volatile LAS unsigned* st) {
    XcdBarrier b; b.bar = bar; b.x = xb_xcc_id(); b.st = st;
    if (threadIdx.x == 0) (void)xb_add(&bar[XB_XCNT(b.x)], 1u);
    return b;
}
__device__ __forceinline__ void xcd_barrier_complete(unsigned* bar, unsigned x, unsigned& nloc, unsigned& nx) {
    const unsigned G = gridDim.x * gridDim.y * gridDim.z;
    unsigned sum, cnt, mine, sp = 0u;
    for (;;) {
        sum = 0u; cnt = 0u; mine = 0u;
#pragma unroll
        for (unsigned j = 0; j < 16; ++j) { const unsigned c = xb_ld(&bar[XB_XCNT(j)]); sum += c; cnt += (c > 0u) ? 1u : 0u; mine = (j == x) ? c : mine; }
        if (sum == G) break;
        __builtin_amdgcn_s_sleep(1);
        if ((++sp & 255u) == 0u) { if (xb_ld(&bar[XB_TMO])) break; if (sp > XB_SPIN_CAP) { atomicAdd(&bar[XB_TMO], 1u); break; } }
    }
    nloc = mine > 0u ? mine : 1u; nx = cnt > 0u ? cnt : 1u;
}

__device__ __forceinline__ void xcd_barrier(const XcdBarrier& b) {
    asm volatile("s_waitcnt vmcnt(0)" ::: "memory");
    __syncthreads();
    if (threadIdx.x == 0) {
        unsigned* bar = b.bar;
        __builtin_amdgcn_s_waitcnt(0);
        unsigned nloc = b.st[0], nx = b.st[1];
        if (nloc == 0u) { xcd_barrier_complete(bar, b.x, nloc, nx); b.st[0] = nloc; b.st[1] = nx; }
        const unsigned old = xb_add(&bar[XB_XSUB(b.x)], 1u);
        const unsigned gen = old / nloc;
        if (old + 1u == (gen + 1u) * nloc) {
            __builtin_amdgcn_fence(__ATOMIC_RELEASE, "agent");
            asm volatile("s_waitcnt vmcnt(0)" ::: "memory");
            const unsigned og = xb_add(&bar[XB_TOP], 1u);
            const unsigned tg = og / nx;
            if (og + 1u == (tg + 1u) * nx) xb_add(&bar[XB_TOPGEN], 1u);
            else XB_SPIN(xb_ld(&bar[XB_TOPGEN]) == tg, bar);
            __builtin_amdgcn_fence(__ATOMIC_ACQUIRE, "agent");
            xb_add(&bar[XB_XGEN(b.x)], 1u);
            asm volatile("s_waitcnt vmcnt(0)" ::: "memory");
        } else {
            XB_SPIN(xb_ld(&bar[XB_XGEN(b.x)]) == gen, bar);
            __builtin_amdgcn_fence(__ATOMIC_ACQUIRE, "agent");
            asm volatile("s_waitcnt vmcnt(0)" ::: "memory");
        }
    }
    __syncthreads();
}


struct Frame;
struct Frame {
    LAS unsigned char* lds;
    int tid, lane, wave, G, bid, z;
    unsigned char* ws;
};
__device__ __forceinline__ void refresh(Frame& F);
#define GIN(i) ((const float*)(GAS const float*)(unsigned long long)A.in[(i) + F.z])
#define WSF(off) ((float*)(F.ws + (off)))
#define WSB(off) ((bf16_t*)(F.ws + (off)))

__device__ __forceinline__ void refresh(Frame& F) { int t = threadIdx.x; asm volatile("" : "+v"(t)); F.tid = t; F.lane = t & 63; F.wave = __builtin_amdgcn_readfirstlane(t >> 6); }
__device__ __forceinline__ int perm32(int rho) { const int n = rho >> 4, i = rho & 15; return 8 * (i >> 2) + 4 * n + (i & 3); }
__device__ __forceinline__ int srccol(int kind, int np) {
    if (kind == 1) { const int t = np >> 8, bj = (np >> 7) & 1, wc = (np >> 5) & 3; return bj * FH + 128 * t + 32 * wc + perm32(np & 31); }
    if (kind == 2 && np < 1024) { const int seg = np >> 9, r = np & 511, G = r >> 5, h = G >> 1, s = G & 1, n = (r >> 4) & 1, i = r & 15; return seg * 512 + h * 64 + 32 * n + 16 * s + i; }
    if ((kind == 2 && np >= 2048) || kind == 3) return (np & ~31) + perm32(np & 31);
    return np;
}
struct CvtMat { const float* W; bf16_t* Bt; int K, N, kind; };
__device__ __forceinline__ void cvt_pick(const Args& A, const Frame& F, int l, int it, CvtMat& m, int& tt) {
    constexpr int T_GU = 16 * 44, T_D = 44 * 8, T_IN = 16 * 56, T_SQ = 16 * 8;
    constexpr int O1 = T_GU, O2 = O1 + T_D, O3 = O2 + T_GU, O4 = O3 + T_D, O5 = O4 + T_IN, O6 = O5 + T_SQ, O7 = O6 + T_SQ;
    const int sel = (it >= O1) + (it >= O2) + (it >= O3) + (it >= O4) + (it >= O5) + (it >= O6) + (it >= O7);
    const int inidx = sel == 0 ? 7 : sel == 1 ? 8 : sel == 2 ? 9 : sel == 3 ? 10 : sel == 4 ? 11 : sel == 5 ? 13 : sel == 6 ? 19 : 20;
    const size_t per_layer = (sel == 0 || sel == 2) ? (size_t)D * 2 * FH : (sel == 1 || sel == 3) ? (size_t)FH * D : sel == 4 ? (size_t)D * PW : (size_t)D * D;
    const size_t woff = sel == 0 ? WS_WGU1 : sel == 1 ? WS_WD1 : sel == 2 ? WS_WGU2 : sel == 3 ? WS_WD2 : sel == 4 ? WS_WIN : sel == 5 ? WS_WRO : sel == 6 ? WS_WLO : WS_WOUT;
    m.W = GIN(inidx) + (size_t)l * per_layer; m.Bt = WSB(woff);
    m.K = (sel == 1 || sel == 3) ? FH : D; m.N = (sel == 0 || sel == 2) ? 2 * FH : (sel == 4 ? PW : D); m.kind = (sel == 0 || sel == 2) ? 1 : (sel == 4 ? 2 : 3);
    tt = it - (sel == 0 ? 0 : sel == 1 ? O1 : sel == 2 ? O2 : sel == 3 ? O3 : sel == 4 ? O4 : sel == 5 ? O5 : sel == 6 ? O6 : O7);
}
__device__ __forceinline__ void cvt_load(const Frame& F, const CvtMat& m, int tt, f32x4 (&v)[4]) {
    const int nb = m.N >> 7, kb = tt / nb, nbk = tt - kb * nb, k0 = kb * 64, n0 = nbk * 128;
    const int src = srccol(m.kind, n0 + (F.tid & 31) * 4);
#pragma unroll
    for (int i = 0; i < 4; ++i) v[i] = *(const f32x4*)(m.W + (size_t)(k0 + (F.tid >> 5) + 16 * i) * m.N + src);
}
__device__ __forceinline__ void cvt_store(const Frame& F, const CvtMat& m, int tt, const f32x4 (&v)[4]) {
    LAS float* tile = (LAS float*)F.lds;
    const int nb = m.N >> 7, kb = tt / nb, nbk = tt - kb * nb, k0 = kb * 64, n0 = nbk * 128;
    const int tid = F.tid;
#pragma unroll
    for (int i = 0; i < 4; ++i) {
        const int kk = (tid >> 5) + 16 * i, nn = (tid & 31) * 4;
        tile[kk * 129 + nn] = v[i][0]; tile[kk * 129 + nn + 1] = v[i][1]; tile[kk * 129 + nn + 2] = v[i][2]; tile[kk * 129 + nn + 3] = v[i][3];
    }
    __syncthreads();
    {
        const int n = tid >> 2, ks = (tid & 3) * 16;
        u32x4 o0, o1;
#pragma unroll
        for (int i = 0; i < 4; ++i) o0[i] = pk2(tile[(ks + 2 * i) * 129 + n], tile[(ks + 2 * i + 1) * 129 + n]);
#pragma unroll
        for (int i = 0; i < 4; ++i) o1[i] = pk2(tile[(ks + 8 + 2 * i) * 129 + n], tile[(ks + 8 + 2 * i + 1) * 129 + n]);
        bf16_t* dst = m.Bt + (size_t)(n0 + n) * m.K + k0 + ks;
        *(u32x4*)dst = o0; *(u32x4*)(dst + 8) = o1;
    }
    __syncthreads();
}
__device__ __forceinline__ void convert_layer(const Args& A, Frame& F, int l) {
    refresh(F);
    constexpr int NT = 2 * 16 * 44 + 2 * 44 * 8 + 16 * 56 + 3 * 16 * 8;
    const int nmy = (NT - F.bid + F.G - 1) / F.G;
    f32x4 v[4];
    { CvtMat m; int tt; cvt_pick(A, F, l, F.bid, m, tt); cvt_load(F, m, tt, v); }
    for (int j = 0; j < nmy; ++j) {
        const int it = F.bid + j * F.G, itn = (j + 1 < nmy) ? it + F.G : it;
        f32x4 vn[4];
        { CvtMat mn; int ttn; cvt_pick(A, F, l, itn, mn, ttn); cvt_load(F, mn, ttn, vn); }
        { CvtMat m; int tt; cvt_pick(A, F, l, it, m, tt); cvt_store(F, m, tt, v); }
#pragma unroll
        for (int i = 0; i < 4; ++i) v[i] = vn[i];
    }
}

__device__ __forceinline__ void mods_phase(const Args& A, Frame& F) {
    refresh(F);
    LAS float* sv = (LAS float*)F.lds;
    LAS float* red = sv + 9 * 1024;
    for (int e = F.tid; e < 9 * 1024; e += NTHREADS) { const int r = e >> 10, k = e & 1023; const float c = r < 8 ? GIN(1)[r * D + k] : GIN(3)[k]; sv[e] = siluf_(c); }
    __syncthreads();
    const int col = F.tid & 127, kq = F.tid >> 7;
    for (int it = F.bid; it < NL * 72; it += F.G) {
        const int l = it / 72, cgp = it - l * 72, n = cgp * 128 + col;
        const float* wp = GIN(4) + (size_t)l * D * NMOD + n;
        float a[9];
#pragma unroll
        for (int r = 0; r < 9; ++r) a[r] = 0.f;
        for (int k0 = kq * 256; k0 < kq * 256 + 256; k0 += 16) {
            float w[16];
#pragma unroll
            for (int j = 0; j < 16; ++j) w[j] = wp[(size_t)(k0 + j) * NMOD];
#pragma unroll
            for (int r = 0; r < 9; ++r) {
#pragma unroll
                for (int j4 = 0; j4 < 4; ++j4) {
                    const f32x4 sv4 = *(const LAS f32x4*)(sv + r * 1024 + k0 + 4 * j4);
                    a[r] += sv4[0] * w[4 * j4] + sv4[1] * w[4 * j4 + 1] + sv4[2] * w[4 * j4 + 2] + sv4[3] * w[4 * j4 + 3];
                }
            }
        }
#pragma unroll
        for (int r = 0; r < 9; ++r) red[(kq * 9 + r) * 128 + col] = a[r];
        __syncthreads();
        for (int e = F.tid; e < 9 * 128; e += NTHREADS) {
            const int r = e >> 7, c2 = e & 127, n2 = cgp * 128 + c2;
            const float s = red[(0 * 9 + r) * 128 + c2] + red[(1 * 9 + r) * 128 + c2] + red[(2 * 9 + r) * 128 + c2] + red[(3 * 9 + r) * 128 + c2];
            WSF(WS_MODS)[(size_t)(l * 9 + r) * NMOD + n2] = s + GIN(5)[(size_t)l * NMOD + n2];
        }
        __syncthreads();
    }
}
__device__ __forceinline__ void init_phase(const Args& A, Frame& F) {
    refresh(F);
    const size_t nunits = (size_t)MROWS * D / 4;
    for (size_t uidx = (size_t)F.bid * NTHREADS + F.tid; uidx < nunits; uidx += (size_t)F.G * NTHREADS) {
        const size_t row = uidx >> 8; const int c4 = (int)(uidx & 255) * 4;
        const int b = (int)(row / TB), p = (int)(row - (size_t)b * TB);
        const float* src = p < CTXL ? GIN(2) + ((size_t)b * CTXL + p) * D + c4 : GIN(0) + ((size_t)b * SEQ + (p - CTXL)) * D + c4;
        { const f32x4 xv = *(const f32x4*)src; u32x2 o; o.x = pk2(xv[0], xv[1]); o.y = pk2(xv[2], xv[3]); *(u32x2*)(WSB(WS_R) + row * D + c4) = o; }
    }
    for (int e = F.bid * NTHREADS + F.tid; e < SEQ * 32; e += F.G * NTHREADS) {
        const int t = e >> 5, j = e & 31, f = j & 15;
        const float pos = j < 16 ? (float)(t >> 6) : (float)(t & 63);
        const float inv = powf(10000.f, -(float)f / 16.f);
        float s, c; sincosf(pos * inv, &s, &c);
        WSF(WS_ROPE)[e] = c; WSF(WS_ROPE)[SEQ * 32 + e] = s;
    }
}

__device__ __forceinline__ void norm_phase(const Args& A, Frame& F, int l, int s, bool latonly, bool tailsum) {
    refresh(F);
    const float* g = GIN(6) + (size_t)(l * 3 + s) * D;
    for (int row = F.bid * 8 + F.wave; row < MROWS; row += F.G * 8) {
        const int b = row / TB, p = row - b * TB, mr = p < CTXL ? 8 : b;
        if (latonly && p < CTXL) continue;
        const u32x2* xr = (const u32x2*)(WSB(WS_R) + (size_t)row * D) + F.lane;
        f32x4 v[4]; float ss = 0.f;
#pragma unroll
        for (int j = 0; j < 4; ++j) { const u32x2 xv = xr[64 * j]; v[j][0] = bflo(xv.x); v[j][1] = bfhi(xv.x); v[j][2] = bflo(xv.y); v[j][3] = bfhi(xv.y); }
        if (tailsum && row >= 16384) {
#pragma unroll
            for (int sp = 0; sp < 8; ++sp) {
                const u32x2* pr = (const u32x2*)(WSB(WS_PART) + ((size_t)sp * 2048 + (row - 16384)) * D) + F.lane;
#pragma unroll
                for (int j = 0; j < 4; ++j) { const u32x2 pv = pr[64 * j]; v[j][0] += bflo(pv.x); v[j][1] += bfhi(pv.x); v[j][2] += bflo(pv.y); v[j][3] += bfhi(pv.y); }
            }
            u32x2* xw = (u32x2*)(WSB(WS_R) + (size_t)row * D) + F.lane;
#pragma unroll
            for (int j = 0; j < 4; ++j) { u32x2 o; o.x = pk2(v[j][0], v[j][1]); o.y = pk2(v[j][2], v[j][3]); xw[64 * j] = o; v[j][0] = bflo(o.x); v[j][1] = bfhi(o.x); v[j][2] = bflo(o.y); v[j][3] = bfhi(o.y); }
        }
#pragma unroll
        for (int j = 0; j < 4; ++j) ss += (v[j][0] * v[j][0] + v[j][1] * v[j][1]) + (v[j][2] * v[j][2] + v[j][3] * v[j][3]);
        const float rstd = rsqrtf(wave_sum(ss) * (1.f / D) + EPS);
        const float* mp = WSF(WS_MODS) + (size_t)(l * 9 + mr) * NMOD + (size_t)(3 * s) * D;
        u32x2* o8 = (u32x2*)(WSB(WS_AN) + (size_t)row * D) + F.lane;
#pragma unroll
        for (int j = 0; j < 4; ++j) {
            const int col = 4 * (F.lane + 64 * j);
            const f32x4 gv = *(const f32x4*)(g + col), sh = *(const f32x4*)(mp + col), sc = *(const f32x4*)(mp + D + col);
            const f32x4 y = (v[j] * rstd * gv) * (sc + 1.f) + sh;
            u32x2 o; o.x = pk2(y[0], y[1]); o.y = pk2(y[2], y[3]);
            o8[64 * j] = o;
        }
    }
}
__device__ __forceinline__ void final_phase(const Args& A, Frame& F) {
    refresh(F);
    const float* g = GIN(21);
    for (int r = F.bid * 8 + F.wave; r < NB * SEQ; r += F.G * 8) {
        const int b = r >> 11, t = r & 2047;
        const u32x2* xr = (const u32x2*)(WSB(WS_R) + ((size_t)b * TB + CTXL + t) * D) + F.lane;
        f32x4 v[4]; float ss = 0.f;
#pragma unroll
        for (int j = 0; j < 4; ++j) { const u32x2 xv = xr[64 * j]; v[j][0] = bflo(xv.x); v[j][1] = bfhi(xv.x); v[j][2] = bflo(xv.y); v[j][3] = bfhi(xv.y); ss += (v[j][0] * v[j][0] + v[j][1] * v[j][1]) + (v[j][2] * v[j][2] + v[j][3] * v[j][3]); }
        const float rstd = rsqrtf(wave_sum(ss) * (1.f / D) + EPS);
        f32x4* o = (f32x4*)((float*)(GAS float*)(unsigned long long)A.out + (size_t)r * D) + F.lane;
#pragma unroll
        for (int j = 0; j < 4; ++j) { const f32x4 gv = *(const f32x4*)(g + 4 * (F.lane + 64 * j)); o[64 * j] = v[j] * rstd * gv; }
    }
}

__device__ __forceinline__ float log2_gamma(const Args& A, const Frame& F, int l, int dir, int h) {
    const float x = GIN(12)[(l * 2 + dir) * NH + h];
    return -softplusf_(-x) * 1.4426950408889634f;
}

__device__ __forceinline__ void ret_state_item(const Args& A, Frame& F, int l, int it) {
    refresh(F);
    const int dvh = it & 1, dir = (it >> 1) & 1, h = (it >> 2) & 7, b = it >> 5;
    const int lane = F.lane, fr = lane & 15, fq = lane >> 4, w = F.wave, dvt = w & 3, dkh = w >> 2;
    const float l2g = log2_gamma(A, F, l, dir, h);
    const float cdec = exp2f(128.f * l2g);
    float dec[4][8];
#pragma unroll
    for (int ks = 0; ks < 4; ++ks)
#pragma unroll
        for (int s = 0; s < 8; ++s) { const int a = 32 * ks + 8 * fq + s; dec[ks][s] = exp2f(l2g * (float)(dir ? a : 127 - a)); }
    const int dvrow = 64 * dvh + 16 * dvt + fr;
    const bf16_t* kbase = WSB(WS_KT) + ((size_t)(b * NH + h) * DK + 32 * dkh + fr) * TB;
    const bf16_t* vbase = WSB(WS_VT) + ((size_t)(b * NH + h) * DV + dvrow) * TB;
    f32x4 acc[2];
    acc[0] = (f32x4){0.f, 0.f, 0.f, 0.f}; acc[1] = acc[0];
    bf16x8 ka[4][2], va[4], kb2[4][2], vb2[4];
#define ST_MC(step_) (dir == 0 ? (step_) : ((step_) < 2 ? 1 - (step_) : 19 - (step_)))
#define ST_LOAD(KS, VS, mc_) do { const int _p0 = 128 * (mc_); _Pragma("unroll") for (int ks = 0; ks < 4; ++ks) { VS[ks] = *(const bf16x8*)(vbase + _p0 + 32 * ks + 8 * fq); \
        _Pragma("unroll") for (int t = 0; t < 2; ++t) KS[ks][t] = *(const bf16x8*)(kbase + (size_t)(16 * t) * TB + _p0 + 32 * ks + 8 * fq); } } while (0)
#define ST_STORE(mc_) do { bf16_t* stp = WSB(WS_ST) + ((((size_t)(b * NH + h) * 2 + dir) * NCH + (mc_)) * DV + dvrow) * DK + 32 * dkh + 4 * fq; \
        _Pragma("unroll") for (int t = 0; t < 2; ++t) { u32x2 o; o.x = pk2(acc[t][0], acc[t][1]); o.y = pk2(acc[t][2], acc[t][3]); *(u32x2*)(stp + 16 * t) = o; } } while (0)
#define ST_COMPUTE(KS, VS) do { acc[0] *= cdec; acc[1] *= cdec; _Pragma("unroll") for (int ks = 0; ks < 4; ++ks) { const bf16x8 bv = scale8(VS[ks], dec[ks]); \
        _Pragma("unroll") for (int t = 0; t < 2; ++t) acc[t] = __builtin_amdgcn_mfma_f32_16x16x32_bf16(KS[ks][t], bv, acc[t], 0, 0, 0); } } while (0)
    ST_LOAD(ka, va, ST_MC(0));
    for (int s2 = 0; s2 < NCH; s2 += 2) {
        ST_STORE(ST_MC(s2));
        { const int sn = s2 + 1 < NCH - 1 ? s2 + 1 : NCH - 2; ST_LOAD(kb2, vb2, ST_MC(sn)); }
        ST_COMPUTE(ka, va);
        ST_STORE(ST_MC(s2 + 1));
        if (s2 + 1 == NCH - 1) break;
        { const int sn = s2 + 2 < NCH - 1 ? s2 + 2 : NCH - 2; ST_LOAD(ka, va, ST_MC(sn)); }
        ST_COMPUTE(kb2, vb2);
    }
#undef ST_MC
#undef ST_LOAD
#undef ST_STORE
#undef ST_COMPUTE
}

__device__ __forceinline__ void lru_item(const Args& A, Frame& F, int l, int it) {
    refresh(F);
    const int blk = it & 15, dir = (it >> 4) & 1, b = it >> 5;
    const int tid = F.tid, lane = F.lane, fr = lane & 15, fq = lane >> 4, w = F.wave;
    LAS float* us = (LAS float*)F.lds;
    LAS float* as = us + 128 * 64;
    LAS bf16_t* ub = (LAS bf16_t*)(F.lds + 65536);
    LAS bf16_t* wgs = (LAS bf16_t*)(F.lds + 65536 + 18432);
    LAS float* segA = (LAS float*)(F.lds + 65536 + 2 * 18432);
    LAS float* segB = segA + 512;
    LAS float* hcar = segA + 2048;
    __syncthreads();
    {
        const float* gw = GIN(16) + ((size_t)(l * 2 + dir) * 2) * 16 * 64 * 64;
        for (int e = tid; e < 2 * 64 * 64; e += NTHREADS) {
            const int g = e >> 12, k = (e >> 6) & 63, j = e & 63;
            wgs[(g * 64 + j) * 72 + k] = f2bf(gw[((size_t)(g * 16 + blk) * 64 + k) * 64 + j]);
        }
        if (tid < 128) hcar[tid] = 0.f;
    }
    float bgr[4], bgi[4], spl[4];
#pragma unroll
    for (int nt = 0; nt < 4; ++nt) {
        const int ch = blk * 64 + 16 * nt + fr;
        bgr[nt] = GIN(17)[((size_t)(l * 2 + dir) * 2 + 0) * D + ch];
        bgi[nt] = GIN(17)[((size_t)(l * 2 + dir) * 2 + 1) * D + ch];
        spl[nt] = -8.f * 1.4426950408889634f * softplusf_(-GIN(18)[(size_t)(l * 2 + dir) * D + ch]);
    }
    const int c4 = (tid & 15) * 4, chg = blk * 64 + c4;
    f32x4 cw[4];
#pragma unroll
    for (int j = 0; j < 4; ++j) cw[j] = *(const f32x4*)(GIN(14) + (size_t)(l * 4 + j) * D + chg);
    const f32x4 cb = *(const f32x4*)(GIN(15) + (size_t)l * D + chg);
    const bf16_t* lx = WSB(WS_LX) + (size_t)b * TB * D + chg;
    bf16_t* hout = (dir ? WSB(WS_HB) : WSB(WS_HF)) + (size_t)b * TB * D + blk * 64;
    __syncthreads();
    const int g4 = tid >> 4;
    u32x2 xr[7];
    {
        const int pb0 = dir == 0 ? 0 : 255;
        const int pmin = dir == 0 ? pb0 + 4 * g4 : pb0 - 4 * g4 - 3;
#pragma unroll
        for (int e = 0; e < 7; ++e) { const int q = pmin - 2 + e; const int qc = q < 0 ? 0 : (q >= CTXL ? CTXL - 1 : q); xr[e] = *(const u32x2*)(lx + (size_t)qc * D); }
    }
    for (int sc = 0; sc < NCH; ++sc) {
        const int lo = sc < 2 ? 0 : CTXL, hi = sc < 2 ? CTXL : TB;
        const int pbase = dir == 0 ? 128 * sc : (sc < 2 ? 255 - 128 * sc : 2303 - 128 * (sc - 2));
        {
            const int pmin = dir == 0 ? pbase + 4 * g4 : pbase - 4 * g4 - 3;
            f32x4 xw[7];
#pragma unroll
            for (int e = 0; e < 7; ++e) {
                const int q = pmin - 2 + e;
                const float msk = (q >= lo && q < hi) ? 1.f : 0.f;
                xw[e][0] = bflo(xr[e].x) * msk; xw[e][1] = bfhi(xr[e].x) * msk; xw[e][2] = bflo(xr[e].y) * msk; xw[e][3] = bfhi(xr[e].y) * msk;
            }
#pragma unroll
            for (int m = 0; m < 4; ++m) {
                const f32x4 a = cb + cw[0] * xw[m] + cw[1] * xw[m + 1] + cw[2] * xw[m + 2] + cw[3] * xw[m + 3];
                const int si = dir == 0 ? 4 * g4 + m : 4 * g4 + 3 - m;
                *(LAS f32x4*)(us + si * 64 + c4) = a;
                u32x2 o; o.x = pk2(a[0], a[1]); o.y = pk2(a[2], a[3]);
                *(LAS u32x2*)(ub + si * 72 + c4) = o;
            }
        }
        {
            const int sn = sc + 1 < NCH ? sc + 1 : sc;
            const int lon = sn < 2 ? 0 : CTXL, hin = sn < 2 ? CTXL : TB;
            const int pbn = dir == 0 ? 128 * sn : (sn < 2 ? 255 - 128 * sn : 2303 - 128 * (sn - 2));
            const int pminn = dir == 0 ? pbn + 4 * g4 : pbn - 4 * g4 - 3;
#pragma unroll
            for (int e = 0; e < 7; ++e) { const int q = pminn - 2 + e; const int qc = q < lon ? lon : (q >= hin ? hin - 1 : q); xr[e] = *(const u32x2*)(lx + (size_t)qc * D); }
        }
        __builtin_amdgcn_fence(__ATOMIC_RELEASE, "workgroup"); __builtin_amdgcn_wave_barrier(); __builtin_amdgcn_fence(__ATOMIC_ACQUIRE, "workgroup");
        {
            bf16x8 af[2];
#pragma unroll
            for (int ks = 0; ks < 2; ++ks) af[ks] = *(const LAS bf16x8*)(ub + (16 * w + fr) * 72 + 32 * ks + 8 * fq);
            f32x4 gacc[8];
#pragma unroll
            for (int nt = 0; nt < 8; ++nt) {
                gacc[nt] = (f32x4){0.f, 0.f, 0.f, 0.f};
#pragma unroll
                for (int ks = 0; ks < 2; ++ks) {
                    const bf16x8 bfm = *(const LAS bf16x8*)(wgs + (16 * nt + fr) * 72 + 32 * ks + 8 * fq);
                    gacc[nt] = __builtin_amdgcn_mfma_f32_16x16x32_bf16(af[ks], bfm, gacc[nt], 0, 0, 0);
                }
            }
#pragma unroll
            for (int nt = 0; nt < 4; ++nt)
#pragma unroll
                for (int r = 0; r < 4; ++r) {
                    const int si = 16 * w + 4 * fq + r, ch = 16 * nt + fr;
                    const float d0 = 1.f + __builtin_amdgcn_exp2f(fminf((gacc[nt][r] + bgr[nt]) * -1.4426950408889634f, 60.f));
                    const float d1 = 1.f + __builtin_amdgcn_exp2f(fminf((gacc[nt + 4][r] + bgi[nt]) * -1.4426950408889634f, 60.f));
                    const float rr = frcp(d0 * d1);
                    const float rg = rr * d1, ig = rr * d0;
                    const float av = __builtin_amdgcn_exp2f(rg * spl[nt]);
                    const float mult = __builtin_amdgcn_sqrtf(fmaxf(1.f - av * av, 0.f));
                    const float uu = us[si * 64 + ch];
                    as[si * 64 + ch] = av;
                    us[si * 64 + ch] = mult * ig * uu;
                }
        }
        __builtin_amdgcn_fence(__ATOMIC_RELEASE, "workgroup"); __builtin_amdgcn_wave_barrier(); __builtin_amdgcn_fence(__ATOMIC_ACQUIRE, "workgroup");
        {
            const int ch = tid & 63, seg = tid >> 6;
            float A = 1.f, Bv = 0.f;
#pragma unroll
            for (int i = 0; i < 16; ++i) { const int si = 16 * seg + i; const float a = as[si * 64 + ch], bb = us[si * 64 + ch]; A *= a; Bv = a * Bv + bb; }
            LAS float* sA = segA + (sc & 1) * 1024; LAS float* sB = segB + (sc & 1) * 1024;
            sA[seg * 64 + ch] = A; sB[seg * 64 + ch] = Bv;
            __syncthreads();
            float hv = hcar[(sc & 1) * 64 + ch];
            for (int s = 0; s < seg; ++s) hv = sA[s * 64 + ch] * hv + sB[s * 64 + ch];
#pragma unroll
            for (int i = 0; i < 16; ++i) {
                const int si = 16 * seg + i; const float a = as[si * 64 + ch], bb = us[si * 64 + ch];
                hv = a * hv + bb;
                const int p = dir == 0 ? pbase + si : pbase - si;
                hout[(size_t)p * D + ch] = f2bf(hv);
            }
            if (seg == 7) hcar[((sc + 1) & 1) * 64 + ch] = hv;
            __builtin_amdgcn_fence(__ATOMIC_RELEASE, "workgroup"); __builtin_amdgcn_wave_barrier(); __builtin_amdgcn_fence(__ATOMIC_ACQUIRE, "workgroup");
        }
    }
    __syncthreads();
}

struct RetPre { u32x4 k[2], sf[2], sb[2], vt[4]; };
__device__ __forceinline__ void ret_prefetch(const Frame& F, int it, int nchu, RetPre& P) {
    const int bh = it / nchu, mc = it - bh * nchu + (NCH - nchu), h = bh & 7, b = bh >> 3;
    const int tid = F.tid;
    const size_t rowbase = (size_t)b * TB + 128 * mc;
#pragma unroll
    for (int i = 0; i < 2; ++i) {
        const int u = tid + i * NTHREADS, r = u >> 3, c8 = (u & 7) * 8;
        P.k[i] = *(const u32x4*)(WSB(WS_KN) + (rowbase + r) * 512 + h * 64 + c8);
        P.sf[i] = *(const u32x4*)(WSB(WS_ST) + ((((size_t)(b * NH + h) * 2 + 0) * NCH + mc) * DV + r) * DK + c8);
        P.sb[i] = *(const u32x4*)(WSB(WS_ST) + ((((size_t)(b * NH + h) * 2 + 1) * NCH + mc) * DV + r) * DK + c8);
    }
#pragma unroll
    for (int i = 0; i < 4; ++i) {
        const int u = tid + i * NTHREADS, r = u >> 4, c8 = (u & 15) * 8;
        P.vt[i] = *(const u32x4*)(WSB(WS_VT) + ((size_t)(b * NH + h) * DV + r) * TB + 128 * mc + c8);
    }
}
__device__ __forceinline__ void ret_out_phase(const Args& A, Frame& F, int l, bool lastl, bf16_t* ARET, bf16_t* ALRU) {
    refresh(F);
    const int tid = F.tid, lane = F.lane, fr = lane & 15, fq = lane >> 4, w = F.wave;
    LAS bf16_t* ks_ = (LAS bf16_t*)F.lds;
    LAS bf16_t* vts = (LAS bf16_t*)(F.lds + 18432);
    LAS bf16_t* sfs = (LAS bf16_t*)(F.lds + 18432 + 34816);
    LAS bf16_t* sbs = (LAS bf16_t*)(F.lds + 2 * 18432 + 34816);
    LAS bf16_t* os = (LAS bf16_t*)(F.lds + 3 * 18432 + 34816);
    const int NCHU = lastl ? NCH - 2 : NCH;
    const int NIT = NB * NH * NCHU;
    const int nmy = (NIT - F.bid + F.G - 1) / F.G;
    RetPre P;
    ret_prefetch(F, F.bid, NCHU, P);
    for (int jx = 0; jx < nmy; ++jx) {
        const int it = F.bid + jx * F.G, itn = (jx + 1 < nmy) ? it + F.G : it;
        const int bh = it / NCHU, mc = it - bh * NCHU + (NCH - NCHU), h = bh & 7, b = bh >> 3;
        const size_t rowbase = (size_t)b * TB + 128 * mc;
        __syncthreads();
#pragma unroll
        for (int i = 0; i < 2; ++i) {
            const int u = tid + i * NTHREADS, r = u >> 3, c8 = (u & 7) * 8;
            *(LAS u32x4*)(ks_ + r * 72 + c8) = P.k[i]; *(LAS u32x4*)(sfs + r * 72 + c8) = P.sf[i]; *(LAS u32x4*)(sbs + r * 72 + c8) = P.sb[i];
        }
#pragma unroll
        for (int i = 0; i < 4; ++i) { const int u = tid + i * NTHREADS, r = u >> 4, c8 = (u & 15) * 8; *(LAS u32x4*)(vts + r * 136 + c8) = P.vt[i]; }
        bf16x8 qf[2];
#pragma unroll
        for (int ks = 0; ks < 2; ++ks) qf[ks] = *(const bf16x8*)(WSB(WS_Q) + (rowbase + 16 * w + fr) * 512 + h * 64 + 32 * ks + 8 * fq);
        __syncthreads();
        ret_prefetch(F, itn, NCHU, P);
        const float l2f = log2_gamma(A, F, l, 0, h), l2b = log2_gamma(A, F, l, 1, h);
        bf16x8 pa[4];
        {
            const int i_loc = 16 * w + fr;
#pragma unroll
            for (int jp = 0; jp < 4; ++jp) {
                f32x4 c0 = (f32x4){0.f, 0.f, 0.f, 0.f}, c1 = c0;
#pragma unroll
                for (int ks = 0; ks < 2; ++ks) {
                    const bf16x8 k0 = *(const LAS bf16x8*)(ks_ + (32 * jp + fr) * 72 + 32 * ks + 8 * fq);
                    const bf16x8 k1 = *(const LAS bf16x8*)(ks_ + (32 * jp + 16 + fr) * 72 + 32 * ks + 8 * fq);
                    c0 = __builtin_amdgcn_mfma_f32_16x16x32_bf16(k0, qf[ks], c0, 0, 0, 0);
                    c1 = __builtin_amdgcn_mfma_f32_16x16x32_bf16(k1, qf[ks], c1, 0, 0, 0);
                }
                float v[8];
#pragma unroll
                for (int r = 0; r < 4; ++r) {
                    const int j0 = 32 * jp + 4 * fq + r, j1 = j0 + 16;
                    const int d0 = i_loc - j0, d1 = i_loc - j1;
                    v[r] = c0[r] * (d0 >= 0 ? exp2f((float)d0 * l2f) : exp2f((float)(-d0) * l2b));
                    v[4 + r] = c1[r] * (d1 >= 0 ? exp2f((float)d1 * l2f) : exp2f((float)(-d1) * l2b));
                }
                u32x4 pv; pv[0] = pk2(v[0], v[1]); pv[1] = pk2(v[2], v[3]); pv[2] = pk2(v[4], v[5]); pv[3] = pk2(v[6], v[7]);
                pa[jp] = __builtin_bit_cast(bf16x8, pv);
            }
        }
        bf16x8 qF[2], qB[2];
        {
            const int il = 16 * w + fr;
            const float sF = exp2f((float)(il + 1) * l2f), sB = exp2f((float)(128 - il) * l2b);
#pragma unroll
            for (int ks = 0; ks < 2; ++ks) { qF[ks] = scale1(qf[ks], sF); qB[ks] = scale1(qf[ks], sB); }
        }
        f32x4 O[8];
#pragma unroll
        for (int dvt = 0; dvt < 8; ++dvt) {
            f32x4 o = (f32x4){0.f, 0.f, 0.f, 0.f};
#pragma unroll
            for (int jp = 0; jp < 4; ++jp) {
                const u32x2 lo = *(const LAS u32x2*)(vts + (16 * dvt + fr) * 136 + 32 * jp + 4 * fq);
                const u32x2 hi = *(const LAS u32x2*)(vts + (16 * dvt + fr) * 136 + 32 * jp + 16 + 4 * fq);
                u32x4 bv; bv[0] = lo.x; bv[1] = lo.y; bv[2] = hi.x; bv[3] = hi.y;
                o = __builtin_amdgcn_mfma_f32_16x16x32_bf16(pa[jp], __builtin_bit_cast(bf16x8, bv), o, 0, 0, 0);
            }
#pragma unroll
            for (int ks = 0; ks < 2; ++ks) {
                const bf16x8 sf = *(const LAS bf16x8*)(sfs + (16 * dvt + fr) * 72 + 32 * ks + 8 * fq);
                const bf16x8 sb = *(const LAS bf16x8*)(sbs + (16 * dvt + fr) * 72 + 32 * ks + 8 * fq);
                o = __builtin_amdgcn_mfma_f32_16x16x32_bf16(qF[ks], sf, o, 0, 0, 0);
                o = __builtin_amdgcn_mfma_f32_16x16x32_bf16(qB[ks], sb, o, 0, 0, 0);
            }
            O[dvt] = o;
            __builtin_amdgcn_sched_barrier(0);
        }
#pragma unroll
        for (int r = 0; r < 4; ++r) {
            float sm = 0.f;
#pragma unroll
            for (int dvt = 0; dvt < 8; ++dvt) sm += O[dvt][r];
            const float mu = sum16(sm) * (1.f / DV);
            float q2 = 0.f;
#pragma unroll
            for (int dvt = 0; dvt < 8; ++dvt) { const float dd = O[dvt][r] - mu; q2 += dd * dd; }
            const float rstd = rsqrtf(sum16(q2) * (1.f / DV) + EPS);
#pragma unroll
            for (int dvt = 0; dvt < 8; ++dvt) os[(16 * w + 4 * fq + r) * 136 + 16 * dvt + fr] = f2bf((O[dvt][r] - mu) * rstd);
        }
        __builtin_amdgcn_fence(__ATOMIC_RELEASE, "workgroup"); __builtin_amdgcn_wave_barrier(); __builtin_amdgcn_fence(__ATOMIC_ACQUIRE, "workgroup");
        {
            const int rr = 16 * w + (lane >> 2), cc = (lane & 3) * 32;
            const size_t go = (rowbase + rr) * D + 128 * h + cc;
#pragma unroll
            for (int i = 0; i < 4; ++i) {
                const u32x4 ov = *(const LAS u32x4*)(os + rr * 136 + cc + 8 * i);
                const u32x4 gv = *(const u32x4*)(WSB(WS_SG) + go + 8 * i);
                u32x4 rv;
#pragma unroll
                for (int e = 0; e < 4; ++e) rv[e] = pk2(bflo(ov[e]) * bflo(gv[e]), bfhi(ov[e]) * bfhi(gv[e]));
                *(u32x4*)(ARET + go + 8 * i) = rv;
            }
        }
#pragma unroll 2
        for (int i = 0; i < 4; ++i) {
            const int u = tid + i * NTHREADS, r = u >> 4, c8 = (u & 15) * 8;
            const size_t o = (rowbase + r) * D + 128 * h + c8;
            const u32x4 hf = *(const u32x4*)(WSB(WS_HF) + o), hb = *(const u32x4*)(WSB(WS_HB) + o), gg = *(const u32x4*)(WSB(WS_GG) + o);
            u32x4 ov;
#pragma unroll
            for (int e = 0; e < 4; ++e) ov[e] = pk2((bflo(hf[e]) + bflo(hb[e])) * bflo(gg[e]), (bfhi(hf[e]) + bfhi(hb[e])) * bfhi(gg[e]));
            *(u32x4*)(ALRU + o) = ov;
        }
    }
    __syncthreads();
}

__global__ void __launch_bounds__(NTHREADS) mega(Args args) {
    extern __shared__ __attribute__((aligned(16))) unsigned char lds_raw[];
    cg::grid_group grid = cg::this_grid();
    Frame F;
    F.lds = (LAS unsigned char*)lds_raw;
    F.tid = threadIdx.x; F.lane = F.tid & 63; F.wave = __builtin_amdgcn_readfirstlane(F.tid >> 6);
    F.G = gridDim.x; F.bid = blockIdx.x;
    volatile LAS unsigned* bst = (volatile LAS unsigned*)(F.lds + LDS_WORK);
    if (F.tid < 4) bst[F.tid] = 0u;
    __syncthreads();
    XcdBarrier xbar = xcd_barrier_post((unsigned*)(args.ws + WS_BAR), bst);
    F.ws = args.ws;
    bf16_t* const ARET = WSB(WS_AN);
    bf16_t* const ALRU = WSB(WS_LX);
    bf16_t* const MB = WSB(WS_SG);

    const int lo = args.ph_lo, hi = args.ph_hi;
    constexpr int NPH = 2 + 12 * NL;
    for (int ph = lo; ph < hi; ++ph) {
        { int z = 0; unsigned long long w = (unsigned long long)args.ws; int bb = (int)blockIdx.x, gg = (int)gridDim.x; asm volatile("" : "+s"(z), "+s"(w), "+s"(bb), "+s"(gg)); F.z = z; F.ws = (unsigned char*)(GAS unsigned char*)w; F.bid = bb; F.G = gg; }
        if (ph == 0) { mods_phase(args, F); init_phase(args, F); convert_layer(args, F, 0); }
        else if (ph == NPH - 1) { final_phase(args, F); }
        else {
            const int l = (ph - 1) / 12, k = (ph - 1) - 12 * l;
            const bool lastl = (l == NL - 1);
            for (int rep = 0; rep < ((PROBE_K >= 0 && k == PROBE_K) ? PROBE_N : 1); ++rep) {
            if (rep > 0) __syncthreads();
            if (k == 0 || k == 3 || k == 9) {
                if (k == 0 && l > 0) convert_layer(args, F, l);
                norm_phase(args, F, l, k == 0 ? 0 : (k == 3 ? 1 : 2), lastl && k == 9, F.G == 256 && !(l == 0 && k == 0) && !(lastl && k == 9));
            } else if (k == 1 || k == 10) {
                const int lat = (lastl && k == 10) ? 1 : 0;
                bf16_t* Bw = k == 1 ? WSB(WS_WGU1) : WSB(WS_WGU2);
                pg8::Gemm g{WSB(WS_AN), WSB(WS_AN), Bw, Bw, D}; pg8::Sched S; S.init(lat ? 64 : 72, 22, F.G, F.bid, 0, lat, 0, D);
                EpiSwiglu E{F.ws}; pg8::build_units(F.lds, S); pg8::gemm_phase(F.lds, g, E);
            } else if (k == 2 || k == 8 || k == 11) {
                const int lat = (lastl && k != 2) ? 1 : 0;
                if (k == 8 && !lat && F.G == 256) {
                    const int row = F.bid * 8 + F.wave;
                    f32x4 v[4];
#pragma unroll
                    for (int j = 0; j < 4; ++j) v[j] = (f32x4){0.f, 0.f, 0.f, 0.f};
#pragma unroll
                    for (int sp = 0; sp < 8; ++sp) {
                        const f32x4* pr = (const f32x4*)(WSF(WS_PART2) + ((size_t)sp * 2048 + row) * D) + F.lane;
#pragma unroll
                        for (int j = 0; j < 4; ++j) v[j] += pr[64 * j];
                    }
                    u32x2* o8 = (u32x2*)(MB + (size_t)(16384 + row) * D) + F.lane;
#pragma unroll
                    for (int j = 0; j < 4; ++j) { u32x2 o; o.x = pk2(v[j][0], v[j][1]); o.y = pk2(v[j][2], v[j][3]); o8[64 * j] = o; }
                    { XcdBarrier xb = xbar; unsigned* bp = xb.bar; unsigned bx = xb.x; asm volatile("" : "+s"(bp), "+s"(bx)); xb.bar = (unsigned*)(GAS unsigned*)(unsigned long long)bp; xb.x = bx; xcd_barrier(xb); }
                }
                bf16_t* Aop = k == 8 ? MB : WSB(WS_H);
                bf16_t* Bw = k == 2 ? WSB(WS_WD1) : (k == 8 ? WSB(WS_WOUT) : WSB(WS_WD2));
                pg8::Gemm g{Aop, Aop, Bw, Bw, k == 8 ? D : FH}; pg8::Sched S; S.init(lat ? 64 : 72, 4, F.G, F.bid, 0, lat, (!lat && F.G == 256) ? 1 : 0, k == 8 ? D : FH);
                EpiRes E{F.ws, l, k == 2 ? 2 : (k == 8 ? 5 : 8), k == 8 ? 1.0f : 0.5f}; pg8::build_units(F.lds, S); pg8::gemm_phase(F.lds, g, E);
            } else if (k == 4) {
                pg8::Gemm g{WSB(WS_AN), WSB(WS_AN), WSB(WS_WIN), WSB(WS_WIN), D}; pg8::Sched S; S.init(72, 28, F.G, F.bid, 0, 0, 0, D);
                EpiWin E{F.ws}; pg8::build_units(F.lds, S); pg8::gemm_phase(F.lds, g, E);
            } else if (k == 5) {
                for (int it = F.bid; it < 512; it += F.G) { if (it < 256) lru_item(args, F, l, it); else ret_state_item(args, F, l, it - 256); }
            } else if (k == 6) {
                ret_out_phase(args, F, l, lastl, ARET, ALRU);
            } else {
                const int lat = lastl ? 1 : 0;
                pg8::Gemm g{ARET, ALRU, WSB(WS_WRO), WSB(WS_WLO), D}; pg8::Sched S; S.init(lat ? 64 : 72, 4, F.G, F.bid, 1, lat, (!lat && F.G == 256) ? 2 : 0, D);
                EpiMerge E{F.ws}; pg8::build_units(F.lds, S); pg8::gemm_phase(F.lds, g, E);
            }
            }
        }
        if (ph + 1 < hi) { if (args.coop == 0x7fffffff) grid.sync();
            { XcdBarrier xb = xbar; unsigned* bp = xb.bar; unsigned bx = xb.x; asm volatile("" : "+s"(bp), "+s"(bx)); xb.bar = (unsigned*)(GAS unsigned*)(unsigned long long)bp; xb.x = bx; xcd_barrier(xb); } }
    }
}

constexpr int N_PHASES = 2 + 12 * NL;

extern "C" void kernel_launch(void* const* d_in, const int* in_sizes, int n_in, void* d_out, int out_size, void* d_ws, size_t ws_size, hipStream_t stream) {
    static int grid = 0;
    if (grid == 0) {
        if (n_in != 22 || ws_size < WS_END) { fprintf(stderr, "kernel_launch: need 22 inputs and %zu bytes of workspace (got %d, %zu)\n", (size_t)WS_END, n_in, ws_size); grid = -1; return; }
        int dev = 0, cus = 0, per_cu = 0;
        hipGetDevice(&dev);
        hipDeviceGetAttribute(&cus, hipDeviceAttributeMultiprocessorCount, dev);
        if (hipFuncSetAttribute((const void*)mega, hipFuncAttributeMaxDynamicSharedMemorySize, LDS_BYTES) != hipSuccess) { fprintf(stderr, "kernel_launch: hipFuncSetAttribute failed\n"); grid = -1; return; }
        if (hipOccupancyMaxActiveBlocksPerMultiprocessor(&per_cu, (const void*)mega, NTHREADS, LDS_BYTES) != hipSuccess || per_cu < 1) { fprintf(stderr, "kernel_launch: occupancy query says %d\n", per_cu); per_cu = 1; }
        (void)hipGetLastError();
        grid = cus * per_cu;
        if (grid > 256) grid = 256;
    }
    if (grid < 0) return;
    if (hipMemsetAsync(d_ws, 0, 16384, stream) != hipSuccess) { fprintf(stderr, "kernel_launch: memset of barrier words failed\n"); return; }
    Args a{};
    for (int i = 0; i < 22; ++i) a.in[i] = (const float*)d_in[i];
    a.out = (float*)d_out; a.ws = (unsigned char*)d_ws;
#if MK_MULTI
    for (int p = 0; p < N_PHASES; ++p) {
        a.ph_lo = p; a.ph_hi = p + 1; a.coop = 0;
        hipLaunchKernelGGL(mega, dim3(grid), dim3(NTHREADS), LDS_BYTES, stream, a);
    }
#else
    a.ph_lo = 0; a.ph_hi = N_PHASES; a.coop = 1;
    void* kargs[] = {&a};
    hipError_t e = hipLaunchCooperativeKernel((const void*)mega, dim3(grid), dim3(NTHREADS), kargs, LDS_BYTES, stream);
    if (e != hipSuccess) fprintf(stderr, "cooperative launch failed: %s (grid %d)\n", hipGetErrorString(e), grid);
#endif
}
```

```cpp
#include <hip/hip_runtime.h>
#include <hip/hip_cooperative_groups.h>
#include <cstdio>
#include <cstdint>
namespace cg = cooperative_groups;

#ifndef PROBE_K
#define PROBE_K -1
#endif
#ifndef PROBE_N
#define PROBE_N 1
#endif
#ifndef MK_MULTI
#define MK_MULTI 0
#endif

#define LAS __attribute__((address_space(3)))
#define GAS __attribute__((address_space(1)))
typedef unsigned short bf16_t;
typedef short bf16x8 __attribute__((ext_vector_type(8)));
typedef float f32x4 __attribute__((ext_vector_type(4)));
typedef unsigned u32x4 __attribute__((ext_vector_type(4)));
typedef unsigned u32x2 __attribute__((ext_vector_type(2)));

constexpr int D = 1024, NB = 8, SEQ = 2048, CTXL = 256, TB = 2304, MROWS = NB * TB, NL = 4, FH = 2816, PW = 7168;
constexpr int NH = 8, DK = 64, DV = 128, NCH = 18, NMOD = 9 * D;
constexpr float EPS = 1e-6f;
constexpr int NTHREADS = 512;
constexpr int LDS_WORK = 131072;
constexpr int LDS_BYTES = LDS_WORK + 1024;

constexpr size_t al256(size_t x) { return (x + 255) & ~(size_t)255; }
constexpr size_t WS_BAR = 0;
constexpr size_t WS_MODS = 16384;
constexpr size_t WS_ROPE = al256(WS_MODS + (size_t)NL * 9 * NMOD * 4);
constexpr size_t WS_WGU1 = al256(WS_ROPE + (size_t)2 * SEQ * 32 * 4);
constexpr size_t WS_WD1 = WS_WGU1 + (size_t)2 * FH * D * 2;
constexpr size_t WS_WGU2 = WS_WD1 + (size_t)FH * D * 2;
constexpr size_t WS_WD2 = WS_WGU2 + (size_t)2 * FH * D * 2;
constexpr size_t WS_WIN = WS_WD2 + (size_t)FH * D * 2;
constexpr size_t WS_WRO = WS_WIN + (size_t)PW * D * 2;
constexpr size_t WS_WLO = WS_WRO + (size_t)D * D * 2;
constexpr size_t WS_WOUT = WS_WLO + (size_t)D * D * 2;
constexpr size_t WS_R = al256(WS_WOUT + (size_t)D * D * 2);
constexpr size_t WS_AN = WS_R + (size_t)MROWS * D * 4;
constexpr size_t WS_ZONE = WS_AN + (size_t)MROWS * D * 2;
constexpr size_t WS_Q = WS_ZONE;
constexpr size_t WS_KN = WS_Q + (size_t)MROWS * 512 * 2;
constexpr size_t WS_KT = WS_KN + (size_t)MROWS * 512 * 2;
constexpr size_t WS_VT = WS_KT + (size_t)MROWS * 512 * 2;
constexpr size_t WS_SG = WS_VT + (size_t)MROWS * D * 2;
constexpr size_t WS_LX = WS_SG + (size_t)MROWS * D * 2;
constexpr size_t WS_GG = WS_LX + (size_t)MROWS * D * 2;
constexpr size_t WS_GA = WS_GG + (size_t)MROWS * D * 2;
constexpr size_t WS_GB = WS_GA + (size_t)MROWS * D * 2;
constexpr size_t WS_ST = WS_GB + (size_t)MROWS * D * 2;
constexpr size_t WS_HF = WS_ST + (size_t)NB * NH * 2 * NCH * DV * DK * 2;
constexpr size_t WS_HB = WS_HF + (size_t)MROWS * D * 2;
constexpr size_t WS_END = WS_HB + (size_t)MROWS * D * 2;
constexpr size_t WS_PART = WS_LX;
constexpr size_t WS_PART2 = WS_ZONE;
constexpr size_t WS_H = WS_ZONE;
constexpr size_t WS_T = WS_ZONE;
static_assert((size_t)MROWS * FH * 2 <= WS_LX - WS_ZONE, "H overlay must not reach the split-K partials");
static_assert((size_t)8 * 2048 * D * 4 <= WS_GA - WS_LX, "partials overlay");
static_assert((size_t)8 * 2048 * D * 4 <= WS_SG - WS_ZONE, "merge partials overlay");
static_assert((size_t)MROWS * D * 4 <= WS_SG - WS_ZONE, "T overlay");

struct Args {
    const float* in[22];
    float* out;
    unsigned char* ws;
    int ph_lo, ph_hi;
    int coop, pad;
};

typedef __bf16 bf16v2_t __attribute__((ext_vector_type(2)));
typedef float f32x2_t __attribute__((ext_vector_type(2)));
__device__ __forceinline__ unsigned pk2(float lo, float hi) { const f32x2_t v = {lo, hi}; const bf16v2_t b = __builtin_convertvector(v, bf16v2_t); return __builtin_bit_cast(unsigned, b); }
__device__ __forceinline__ bf16_t f2bf(float f) { return (bf16_t)(pk2(f, 0.f) & 0xffffu); }
__device__ __forceinline__ float bf2f(bf16_t h) { return __uint_as_float(((unsigned)h) << 16); }
__device__ __forceinline__ float bflo(unsigned u) { return __uint_as_float(u << 16); }
__device__ __forceinline__ float bfhi(unsigned u) { return __uint_as_float(u & 0xffff0000u); }
__device__ __forceinline__ float frcp(float x) { return __builtin_amdgcn_rcpf(x); }
__device__ __forceinline__ float sigmoidf_(float x) { return frcp(1.f + __expf(-x)); }
__device__ __forceinline__ float siluf_(float x) { return x * sigmoidf_(x); }
__device__ __forceinline__ float gelu_tanh_(float x) { const float y = 0.7978845608028654f * (x + 0.044715f * x * x * x); return x * sigmoidf_(2.f * y); }
__device__ __forceinline__ float softplusf_(float x) { return fmaxf(x, 0.f) + log1pf(expf(-fabsf(x))); }
__device__ __forceinline__ float wave_sum(float v) {
#pragma unroll
    for (int o = 1; o < 64; o <<= 1) v += __shfl_xor(v, o);
    return v;
}
__device__ __forceinline__ float sum16(float v) {
#pragma unroll
    for (int o = 1; o < 16; o <<= 1) v += __shfl_xor(v, o);
    return v;
}
__device__ __forceinline__ bf16x8 scale8(bf16x8 f, const float (&s)[8]) {
    u32x4 v = __builtin_bit_cast(u32x4, f);
#pragma unroll
    for (int i = 0; i < 4; ++i) v[i] = pk2(bflo(v[i]) * s[2 * i], bfhi(v[i]) * s[2 * i + 1]);
    return __builtin_bit_cast(bf16x8, v);
}
__device__ __forceinline__ bf16x8 scale1(bf16x8 f, float s) {
    u32x4 v = __builtin_bit_cast(u32x4, f);
#pragma unroll
    for (int i = 0; i < 4; ++i) v[i] = pk2(bflo(v[i]) * s, bfhi(v[i]) * s);
    return __builtin_bit_cast(bf16x8, v);
}

namespace pg8 {
constexpr int BM = 256, BK = 64, HALF = 128, HTB = HALF * BK * 2, NXCD = 8, WGM = 8;
__device__ __forceinline__ int lds_byte(int r, int c) { const int st = (r >> 4) * 2 + (c >> 5), rr = r & 15, cc = c & 31, ob = rr * 64 + cc * 2; return st * 1024 + (ob ^ (((ob >> 9) & 1) << 5)); }
__device__ __forceinline__ void stage_rc(int b, int& R, int& C) { const int st = b / 1024, sb = b % 1024, swz = sb ^ (((sb >> 9) & 1) << 5); R = (st >> 1) * 16 + swz / 64; C = (st & 1) * 32 + (swz % 64) / 2; }

struct Unit { int pm, pn, sub, kt0, nt, sp; };
struct Gemm { const bf16_t* A0; const bf16_t* A1; const bf16_t* B0; const bf16_t* B1; int K; };

struct Sched {
    int nM, nN, G, c, flags, ntK;
    __device__ __forceinline__ void init(int nM_, int nN_, int G_, int c_, int dual_, int latonly_, int tail_, int K_) { nM = tail_ ? 64 : nM_; nN = nN_; G = G_; c = c_; flags = (dual_ ? 1 : 0) | (latonly_ ? 2 : 0) | (tail_ == 1 ? 4 : 0) | (tail_ == 2 ? 8 : 0); ntK = K_ / BK; }
    __device__ __forceinline__ void entry(int i, int& valid, int& pm, int& pn, int& sub, int& kt0, int& nt, int& sp) const {
        const int tidx = (flags & 4) ? 1 : ((flags & 8) ? 2 : 1000);
        const bool tl = i >= tidx;
        const bool tm = (flags & 8) != 0;
        const int tt = c >> 3, spv = c & 7, tpt = ntK >> 1, base = tpt >> 3, rem = tpt & 7;
        const int t_pm = 64 + (tt >> 2), t_pn = tt & 3;
        const int t_kt0 = tm ? 4 * (spv & 3) : 2 * (spv * base + (spv < rem ? spv : rem)), t_nt = tm ? 4 : 2 * (base + (spv < rem ? 1 : 0));
        const int t_sub = tm ? (2 | (spv >> 2)) : 2;
        const int nwg = nM * nN;
        const int ii = (flags & 1) ? (i >> 1) : i;
        const long L = (long)ii * G + c;
        const bool nv = L < nwg;
        int wgid = nv ? (int)L : 0; { const int q = nwg / NXCD, r = nwg % NXCD, xcd = wgid % NXCD, off = wgid / NXCD; wgid = (xcd < r ? xcd * (q + 1) : r * (q + 1) + (xcd - r) * q) + off; }
        const int nig = WGM * nN, gid = wgid / nig, fm = gid * WGM, gsz = (nM - fm) < WGM ? (nM - fm) : WGM;
        int n_pm = fm + ((wgid % nig) % gsz); const int n_pn = (wgid % nig) / gsz;
        if (flags & 2) n_pm = 9 * (n_pm >> 3) + 1 + (n_pm & 7);
        valid = tl ? (i == tidx ? 1 : 0) : (nv ? 1 : 0);
        pm = tl ? t_pm : n_pm; pn = tl ? t_pn : n_pn; sub = tl ? t_sub : ((flags & 1) ? (i & 1) : 0);
        kt0 = tl ? t_kt0 : 0; nt = tl ? t_nt : ntK; sp = tl ? spv : 0;
    }
};

__device__ __forceinline__ bool get_unit(LAS unsigned char* lds, int i, Unit& u) {
    if (i >= 16) return false;
    const LAS int* e = (const LAS int*)(lds + 131072 + 64) + 8 * i;
    const int valid = __builtin_amdgcn_readfirstlane(e[0]);
    u.pm = __builtin_amdgcn_readfirstlane(e[1]); u.pn = __builtin_amdgcn_readfirstlane(e[2]); u.sub = __builtin_amdgcn_readfirstlane(e[3]);
    u.kt0 = __builtin_amdgcn_readfirstlane(e[4]); u.nt = __builtin_amdgcn_readfirstlane(e[5]); u.sp = __builtin_amdgcn_readfirstlane(e[6]);
    return valid != 0;
}
__device__ __forceinline__ void build_units(LAS unsigned char* lds, const Sched& S) {
    const int t = threadIdx.x;
    if (t < 16) {
        int valid, pm, pn, sub, kt0, nt, sp;
        S.entry(t, valid, pm, pn, sub, kt0, nt, sp);
        asm volatile("" : "+v"(kt0), "+v"(nt), "+v"(sp), "+v"(valid));
        LAS int* e = (LAS int*)(lds + 131072 + 64) + 8 * t;
        e[0] = valid; e[1] = pm; e[2] = pn; e[3] = sub; e[4] = kt0; e[5] = nt; e[6] = sp; e[7] = 0;
    }
    __syncthreads();
}

template <class Epi>
__device__ __forceinline__ void gemm_phase(LAS unsigned char* lds, const Gemm g, const Epi& E) {
    int tid = threadIdx.x; asm volatile("" : "+v"(tid));
    const int wid = __builtin_amdgcn_readfirstlane(tid >> 6), lane = tid & 63, wr = wid >> 2, wc = wid & 3, fr = lane & 15, fq = lane >> 4;
    const int K = g.K;
    unsigned voffA[2];
#pragma unroll
    for (int i = 0; i < 2; ++i) { int R, C; stage_rc(tid * 16 + i * 8192, R, C); voffA[i] = (unsigned)(R * K + C) * 2u; }
    const size_t kstep = (size_t)(BK * 2);
    const size_t hstep = (size_t)HALF * K * 2;
    const size_t tstep = 2 * hstep;
    const unsigned ldsw = (unsigned)wid * 1024u;
    const int aoff = lds_byte(wr * 64 + fr, fq * 8), boff = lds_byte(wc * 32 + fr, fq * 8);
#define PG8_SA(b, h) (((b) * 2 + (h)) * HTB)
#define PG8_SB(b, h) ((4 + (b) * 2 + (h)) * HTB)
#define PG8_STAGE(bufoff, gbase, voff) do { _Pragma("unroll") for (int _i = 0; _i < 2; ++_i) \
        __builtin_amdgcn_global_load_lds((const unsigned*)((const char*)(gbase) + (voff)[_i]), (LAS unsigned*)(lds + (bufoff) + ldsw + _i * 8192), 16, 0, 0); } while (0)
#define PG8_LDA(dst, b, h) do { _Pragma("unroll") for (int m = 0; m < 4; ++m) _Pragma("unroll") for (int k = 0; k < 2; ++k) dst[m][k] = *(const LAS bf16x8*)(lds + PG8_SA(b, h) + aoff + m * 2048 + k * 1024); } while (0)
#define PG8_LDB(dst, b, h) do { _Pragma("unroll") for (int n = 0; n < 2; ++n) _Pragma("unroll") for (int k = 0; k < 2; ++k) dst[n][k] = *(const LAS bf16x8*)(lds + PG8_SB(b, h) + boff + n * 2048 + k * 1024); } while (0)
#define PG8_MMA(ai, bj, At, Bt) do { __builtin_amdgcn_s_setprio(1); _Pragma("unroll") for (int m = 0; m < 4; ++m) _Pragma("unroll") for (int n = 0; n < 2; ++n) _Pragma("unroll") for (int k = 0; k < 2; ++k) \
        acc[ai][bj][m][n] = __builtin_amdgcn_mfma_f32_16x16x32_bf16(Bt[n][k], At[m][k], acc[ai][bj][m][n], 0, 0, 0); __builtin_amdgcn_s_setprio(0); } while (0)
#define PG8_WAIT_V(n) asm volatile("s_waitcnt vmcnt(" #n ")" ::: "memory")
#define PG8_WAIT_L(n) asm volatile("s_waitcnt lgkmcnt(" #n ")" ::: "memory")
#define PG8_BAR __builtin_amdgcn_s_barrier()
#define PG8_SCHED __builtin_amdgcn_sched_barrier(0)
    Unit cur; int ui = 0;
    if (!get_unit(lds, 0, cur)) return;
    f32x4 acc[2][2][4][2];
#pragma unroll
    for (int a = 0; a < 2; ++a)
#pragma unroll
        for (int b = 0; b < 2; ++b)
#pragma unroll
            for (int m = 0; m < 4; ++m)
#pragma unroll
                for (int n = 0; n < 2; ++n) acc[a][b][m][n] = (f32x4){0.f, 0.f, 0.f, 0.f};
    bf16x8 At[4][2], B0[2][2], B1[2][2];
    const char* cA = (const char*)((cur.sub & 1) ? g.A1 : g.A0) + (size_t)cur.pm * tstep + (size_t)cur.kt0 * kstep; const char* cB = (const char*)((cur.sub & 1) ? g.B1 : g.B0) + (size_t)cur.pn * tstep + (size_t)cur.kt0 * kstep;
    PG8_STAGE(PG8_SB(0, 0), cB, voffA); PG8_STAGE(PG8_SB(0, 1), cB + hstep, voffA); PG8_STAGE(PG8_SA(0, 0), cA, voffA); PG8_STAGE(PG8_SA(0, 1), cA + hstep, voffA);
    if (wr == 1) PG8_BAR;
    PG8_WAIT_V(2); PG8_BAR;
    PG8_STAGE(PG8_SB(1, 0), cB + kstep, voffA); PG8_STAGE(PG8_SA(1, 0), cA + kstep, voffA); PG8_STAGE(PG8_SB(1, 1), cB + hstep + kstep, voffA);
    PG8_WAIT_V(6); PG8_BAR;
    for (;;) {
        Unit nxt; const bool has_next = get_unit(lds, ui + 1, nxt);
        const char* nA = has_next ? (const char*)((nxt.sub & 1) ? g.A1 : g.A0) + (size_t)nxt.pm * tstep + (size_t)nxt.kt0 * kstep : cA; const char* nB = has_next ? (const char*)((nxt.sub & 1) ? g.B1 : g.B0) + (size_t)nxt.pn * tstep + (size_t)nxt.kt0 * kstep : cB;
        const int nt = cur.nt;
        for (int t = 0; t < nt; t += 2) {
            const bool last = (t == nt - 2);
            const char* a1 = cA + (size_t)(t + 1) * kstep;
            const char* a2 = last ? nA : cA + (size_t)(t + 2) * kstep; const char* b2 = last ? nB : cB + (size_t)(t + 2) * kstep;
            const char* a3 = a2 + kstep; const char* b3 = b2 + kstep;
            PG8_LDB(B0, 0, 0); PG8_LDB(B1, 0, 1); PG8_SCHED; PG8_LDA(At, 0, 0); PG8_STAGE(PG8_SA(1, 1), a1 + hstep, voffA);
            PG8_WAIT_V(8); PG8_WAIT_L(0); PG8_BAR; PG8_MMA(0, 0, At, B0); PG8_MMA(0, 1, At, B1); PG8_BAR; PG8_SCHED;
            PG8_LDA(At, 0, 1); PG8_STAGE(PG8_SB(0, 0), b2, voffA); PG8_STAGE(PG8_SB(0, 1), b2 + hstep, voffA); PG8_STAGE(PG8_SA(0, 0), a2, voffA);
            PG8_WAIT_V(8); PG8_WAIT_L(0); PG8_BAR; PG8_MMA(1, 0, At, B0); PG8_MMA(1, 1, At, B1); PG8_BAR; PG8_SCHED;
            PG8_LDB(B0, 1, 0); PG8_LDB(B1, 1, 1); PG8_SCHED; PG8_LDA(At, 1, 0); PG8_STAGE(PG8_SA(0, 1), a2 + hstep, voffA);
            PG8_WAIT_V(8); PG8_WAIT_L(0); PG8_BAR; PG8_MMA(0, 0, At, B0); PG8_MMA(0, 1, At, B1); PG8_BAR; PG8_SCHED;
            PG8_LDA(At, 1, 1); PG8_STAGE(PG8_SB(1, 0), b3, voffA); PG8_STAGE(PG8_SB(1, 1), b3 + hstep, voffA); PG8_STAGE(PG8_SA(1, 0), a3, voffA);
            PG8_WAIT_V(8); PG8_WAIT_L(0); PG8_BAR; PG8_MMA(1, 0, At, B0); PG8_MMA(1, 1, At, B1); PG8_BAR; PG8_SCHED;
        }
        if (wr == 0) PG8_BAR;
        E(acc, cur, wr, wc, fr, fq);
        if (!has_next) break;
        if (!(Epi::KEEP && cur.sub == 0))
#pragma unroll
        for (int a = 0; a < 2; ++a)
#pragma unroll
            for (int b = 0; b < 2; ++b)
#pragma unroll
                for (int m = 0; m < 4; ++m)
#pragma unroll
                    for (int n = 0; n < 2; ++n) acc[a][b][m][n] = (f32x4){0.f, 0.f, 0.f, 0.f};
        ++ui; get_unit(lds, ui, cur); cA = nA; cB = nB;
        if (wr == 1) PG8_BAR;
    }
    PG8_WAIT_V(0);
    PG8_BAR;
#undef PG8_SA
#undef PG8_SB
#undef PG8_STAGE
#undef PG8_LDA
#undef PG8_LDB
#undef PG8_MMA
#undef PG8_WAIT_V
#undef PG8_WAIT_L
#undef PG8_BAR
#undef PG8_SCHED
}
}

typedef f32x4 AccT[2][2][4][2];

struct EpiRes {
    static constexpr bool KEEP = false;
    unsigned char* ws; int l; int gidx; float fac;
    __device__ __forceinline__ void operator()(const AccT& acc, const pg8::Unit& u, int wr, int wc, int fr_, int fq_) const {
        int fr = fr_, fq = fq_; asm volatile("" : "+v"(fr), "+v"(fq));
        const int b = u.pm / 9, pt = u.pm - 9 * b, mr = pt == 0 ? 8 : b;
        const int row0 = u.pm * 256 + wr * 64 + fr, col0 = u.pn * 256 + wc * 32 + 8 * fq;
        const float* mp = (const float*)(ws + WS_MODS) + ((size_t)(l * 9 + mr) * NMOD + (size_t)gidx * D);
        bf16_t* R = (bf16_t*)(ws + WS_R);
        f32x4 gv[2][2];
#pragma unroll
        for (int bj = 0; bj < 2; ++bj)
#pragma unroll
            for (int n = 0; n < 2; ++n) gv[bj][n] = *(const f32x4*)(mp + col0 + bj * 128 + n * 4) * fac;
        if (u.sub & 2) {
            bf16_t* P = (bf16_t*)(ws + WS_PART) + (size_t)u.sp * (2048 * D);
#pragma unroll
            for (int ai = 0; ai < 2; ++ai)
#pragma unroll
                for (int m = 0; m < 4; ++m) {
                    bf16_t* rowp = P + (size_t)(row0 - 16384 + ai * 128 + m * 16) * D + col0;
#pragma unroll
                    for (int bj = 0; bj < 2; ++bj) {
                        const f32x4 t0 = gv[bj][0] * acc[ai][bj][m][0], t1 = gv[bj][1] * acc[ai][bj][m][1];
                        u32x4 o; o[0] = pk2(t0[0], t0[1]); o[1] = pk2(t0[2], t0[3]); o[2] = pk2(t1[0], t1[1]); o[3] = pk2(t1[2], t1[3]);
                        *(u32x4*)(rowp + bj * 128) = o;
                    }
                }
            return;
        }
#pragma unroll
        for (int ai = 0; ai < 2; ++ai)
#pragma unroll
            for (int m = 0; m < 4; ++m) {
                bf16_t* rowp = R + (size_t)(row0 + ai * 128 + m * 16) * D + col0;
#pragma unroll
                for (int bj = 0; bj < 2; ++bj) {
                    const u32x4 rv = *(const u32x4*)(rowp + bj * 128);
                    f32x4 r0, r1; r0[0] = bflo(rv[0]); r0[1] = bfhi(rv[0]); r0[2] = bflo(rv[1]); r0[3] = bfhi(rv[1]); r1[0] = bflo(rv[2]); r1[1] = bfhi(rv[2]); r1[2] = bflo(rv[3]); r1[3] = bfhi(rv[3]);
                    r0 += gv[bj][0] * acc[ai][bj][m][0]; r1 += gv[bj][1] * acc[ai][bj][m][1];
                    u32x4 o; o[0] = pk2(r0[0], r0[1]); o[1] = pk2(r0[2], r0[3]); o[2] = pk2(r1[0], r1[1]); o[3] = pk2(r1[2], r1[3]);
                    *(u32x4*)(rowp + bj * 128) = o;
                }
            }
    }
};

struct EpiSwiglu {
    static constexpr bool KEEP = false;
    unsigned char* ws;
    __device__ __forceinline__ void operator()(const AccT& acc, const pg8::Unit& u, int wr, int wc, int fr_, int fq_) const {
        int fr = fr_, fq = fq_; asm volatile("" : "+v"(fr), "+v"(fq));
        const int row0 = u.pm * 256 + wr * 64 + fr;
        bf16_t* H = (bf16_t*)(ws + WS_H) + 128 * u.pn + 32 * wc + 8 * fq;
#pragma unroll
        for (int ai = 0; ai < 2; ++ai)
#pragma unroll
            for (int m = 0; m < 4; ++m) {
                const f32x4 u0 = acc[ai][0][m][0], u1 = acc[ai][0][m][1], v0 = acc[ai][1][m][0], v1 = acc[ai][1][m][1];
                u32x4 o;
                o[0] = pk2(siluf_(u0[0]) * v0[0], siluf_(u0[1]) * v0[1]); o[1] = pk2(siluf_(u0[2]) * v0[2], siluf_(u0[3]) * v0[3]);
                o[2] = pk2(siluf_(u1[0]) * v1[0], siluf_(u1[1]) * v1[1]); o[3] = pk2(siluf_(u1[2]) * v1[2], siluf_(u1[3]) * v1[3]);
                *(u32x4*)(H + (size_t)(row0 + ai * 128 + m * 16) * FH) = o;
            }
    }
};

struct EpiWin {
    static constexpr bool KEEP = false;
    unsigned char* ws;
    __device__ __forceinline__ void operator()(const AccT& acc, const pg8::Unit& u, int wr, int wc, int fr_, int fq_) const {
        int fr = fr_, fq = fq_; asm volatile("" : "+v"(fr), "+v"(fq));
        const int b = u.pm / 9, pt = u.pm - 9 * b;
        const int pn = u.pn;
        const float* rope = (const float*)(ws + WS_ROPE);
        bf16_t* const Q = (bf16_t*)(ws + WS_Q); bf16_t* const KN = (bf16_t*)(ws + WS_KN); bf16_t* const KT = (bf16_t*)(ws + WS_KT); bf16_t* const VT = (bf16_t*)(ws + WS_VT);
        const int rl0 = wr * 64 + fr;
        if (pn < 4) {
            const bool isk = pn >= 2;
            const int jj0 = 16 * (wc & 1) + 4 * fq;
#pragma unroll
            for (int ai = 0; ai < 2; ++ai)
#pragma unroll
                for (int m = 0; m < 4; ++m) {
                    const int rl = rl0 + ai * 128 + m * 16;
                    const size_t row = (size_t)u.pm * 256 + rl;
                    f32x4 cs = (f32x4){1.f, 1.f, 1.f, 1.f}, sn = (f32x4){0.f, 0.f, 0.f, 0.f};
                    if (pt != 0) { const int tpos = (pt - 1) * 256 + rl; cs = *(const f32x4*)(rope + (size_t)tpos * 32 + jj0); sn = *(const f32x4*)(rope + (size_t)SEQ * 32 + (size_t)tpos * 32 + jj0); }
#pragma unroll
                    for (int bj = 0; bj < 2; ++bj) {
                        const int hq = 4 * (pn & 1) + 2 * bj + (wc >> 1);
                        const f32x4 a1 = acc[ai][bj][m][0], a2 = acc[ai][bj][m][1];
                        f32x4 o1 = a1 * cs - a2 * sn, o2 = a1 * sn + a2 * cs;
                        if (isk) { o1 *= 0.125f; o2 *= 0.125f; }
                        u32x2 p1, p2; p1.x = pk2(o1[0], o1[1]); p1.y = pk2(o1[2], o1[3]); p2.x = pk2(o2[0], o2[1]); p2.y = pk2(o2[2], o2[3]);
                        bf16_t* dst = (isk ? KN : Q) + row * 512 + hq * 64 + jj0;
                        *(u32x2*)dst = p1; *(u32x2*)(dst + 32) = p2;
                        if (isk) {
                            bf16_t* kt = KT + ((size_t)(b * NH + hq) * DK + jj0) * TB + pt * 256 + rl;
                            kt[0] = (bf16_t)(p1.x & 0xffffu); kt[(size_t)TB] = (bf16_t)(p1.x >> 16); kt[(size_t)2 * TB] = (bf16_t)(p1.y & 0xffffu); kt[(size_t)3 * TB] = (bf16_t)(p1.y >> 16);
                            bf16_t* kt2 = kt + (size_t)32 * TB;
                            kt2[0] = (bf16_t)(p2.x & 0xffffu); kt2[(size_t)TB] = (bf16_t)(p2.x >> 16); kt2[(size_t)2 * TB] = (bf16_t)(p2.y & 0xffffu); kt2[(size_t)3 * TB] = (bf16_t)(p2.y >> 16);
                        }
                    }
                    __builtin_amdgcn_sched_barrier(0);
                }
        } else if (pn < 8) {
#pragma unroll
            for (int ai = 0; ai < 2; ++ai)
#pragma unroll
                for (int m = 0; m < 4; ++m) {
                    const int rl = rl0 + ai * 128 + m * 16;
#pragma unroll
                    for (int bj = 0; bj < 2; ++bj) {
                        const int hv = 2 * (pn - 4) + bj;
#pragma unroll
                        for (int n = 0; n < 2; ++n) {
                            const int dv = 32 * wc + 16 * n + 4 * fq;
                            bf16_t* vt = VT + ((size_t)(b * NH + hv) * DV + dv) * TB + pt * 256 + rl;
                            const f32x4 a = acc[ai][bj][m][n];
                            const unsigned p0 = pk2(a[0], a[1]), p1 = pk2(a[2], a[3]);
                            vt[0] = (bf16_t)(p0 & 0xffffu); vt[(size_t)TB] = (bf16_t)(p0 >> 16); vt[(size_t)2 * TB] = (bf16_t)(p1 & 0xffffu); vt[(size_t)3 * TB] = (bf16_t)(p1 >> 16);
                        }
                        __builtin_amdgcn_sched_barrier(0);
                    }
                }
        } else {
            const int seg = (pn - 8) >> 2;
            bf16_t* base = (bf16_t*)(ws + WS_SG + (size_t)seg * ((size_t)MROWS * D * 2));
            const int cbase = 256 * ((pn - 8) & 3) + wc * 32 + 8 * fq;
#pragma unroll
            for (int ai = 0; ai < 2; ++ai)
#pragma unroll
                for (int m = 0; m < 4; ++m) {
                    const size_t row = (size_t)u.pm * 256 + rl0 + ai * 128 + m * 16;
#pragma unroll
                    for (int bj = 0; bj < 2; ++bj) {
                        f32x4 a0 = acc[ai][bj][m][0], a1 = acc[ai][bj][m][1];
                        if (seg == 0) { a0[0] = siluf_(a0[0]); a0[1] = siluf_(a0[1]); a0[2] = siluf_(a0[2]); a0[3] = siluf_(a0[3]); a1[0] = siluf_(a1[0]); a1[1] = siluf_(a1[1]); a1[2] = siluf_(a1[2]); a1[3] = siluf_(a1[3]); }
                        else if (seg == 2) { a0[0] = gelu_tanh_(a0[0]); a0[1] = gelu_tanh_(a0[1]); a0[2] = gelu_tanh_(a0[2]); a0[3] = gelu_tanh_(a0[3]); a1[0] = gelu_tanh_(a1[0]); a1[1] = gelu_tanh_(a1[1]); a1[2] = gelu_tanh_(a1[2]); a1[3] = gelu_tanh_(a1[3]); }
                        else if (seg >= 3) { a0[0] = sigmoidf_(a0[0]); a0[1] = sigmoidf_(a0[1]); a0[2] = sigmoidf_(a0[2]); a0[3] = sigmoidf_(a0[3]); a1[0] = sigmoidf_(a1[0]); a1[1] = sigmoidf_(a1[1]); a1[2] = sigmoidf_(a1[2]); a1[3] = sigmoidf_(a1[3]); }
                        u32x4 o; o[0] = pk2(a0[0], a0[1]); o[1] = pk2(a0[2], a0[3]); o[2] = pk2(a1[0], a1[1]); o[3] = pk2(a1[2], a1[3]);
                        *(u32x4*)(base + row * D + cbase + bj * 128) = o;
                    }
                }
        }
    }
};

struct EpiMerge {
    static constexpr bool KEEP = true;
    unsigned char* ws;
    __device__ __forceinline__ void operator()(AccT& acc, const pg8::Unit& u, int wr, int wc, int fr_, int fq_) const {
        int fr = fr_, fq = fq_; asm volatile("" : "+v"(fr), "+v"(fq));
        const int row0 = u.pm * 256 + wr * 64 + fr, col0 = u.pn * 256 + wc * 32 + 8 * fq;
        const bf16_t* GA = (const bf16_t*)(ws + WS_GA); const bf16_t* GB = (const bf16_t*)(ws + WS_GB);
        bf16_t* MB = (bf16_t*)(ws + WS_SG);
        if (u.sub & 2) {
            const bf16_t* G = (u.sub & 1) ? GB : GA;
            bf16_t* P = (bf16_t*)(ws + WS_PART2) + (size_t)u.sp * (2048 * D);
#pragma unroll
            for (int ai = 0; ai < 2; ++ai)
#pragma unroll
                for (int m = 0; m < 4; ++m) {
                    const size_t ro = (size_t)(row0 + ai * 128 + m * 16) * D + col0;
                    const size_t po = (size_t)(row0 - 16384 + ai * 128 + m * 16) * D + col0;
#pragma unroll
                    for (int bj = 0; bj < 2; ++bj) {
                        const u32x4 gv = *(const u32x4*)(G + ro + bj * 128);
                        f32x4 s0, s1; s0[0] = bflo(gv[0]); s0[1] = bfhi(gv[0]); s0[2] = bflo(gv[1]); s0[3] = bfhi(gv[1]); s1[0] = bflo(gv[2]); s1[1] = bfhi(gv[2]); s1[2] = bflo(gv[3]); s1[3] = bfhi(gv[3]);
                        const f32x4 t0 = s0 * acc[ai][bj][m][0], t1 = s1 * acc[ai][bj][m][1];
                        u32x4 o; o[0] = pk2(t0[0], t0[1]); o[1] = pk2(t0[2], t0[3]); o[2] = pk2(t1[0], t1[1]); o[3] = pk2(t1[2], t1[3]);
                        *(u32x4*)(P + po + bj * 128) = o;
                    }
                }
            return;
        }
#pragma unroll
        for (int ai = 0; ai < 2; ++ai)
#pragma unroll
            for (int m = 0; m < 4; ++m) {
                const size_t ro = (size_t)(row0 + ai * 128 + m * 16) * D + col0;
#pragma unroll
                for (int bj = 0; bj < 2; ++bj) {
                    const size_t o = ro + bj * 128;
                    const u32x4 gb = *(const u32x4*)(GB + o);
                    f32x4 b0, b1;
                    b0[0] = fmaxf(bflo(gb[0]), 1e-6f); b0[1] = fmaxf(bfhi(gb[0]), 1e-6f); b0[2] = fmaxf(bflo(gb[1]), 1e-6f); b0[3] = fmaxf(bfhi(gb[1]), 1e-6f);
                    b1[0] = fmaxf(bflo(gb[2]), 1e-6f); b1[1] = fmaxf(bfhi(gb[2]), 1e-6f); b1[2] = fmaxf(bflo(gb[3]), 1e-6f); b1[3] = fmaxf(bfhi(gb[3]), 1e-6f);
                    if ((u.sub & 1) == 0) {
                        const u32x4 ga = *(const u32x4*)(GA + o);
                        f32x4 a0, a1; a0[0] = bflo(ga[0]); a0[1] = bfhi(ga[0]); a0[2] = bflo(ga[1]); a0[3] = bfhi(ga[1]); a1[0] = bflo(ga[2]); a1[1] = bfhi(ga[2]); a1[2] = bflo(ga[3]); a1[3] = bfhi(ga[3]);
#pragma unroll
                        for (int j = 0; j < 4; ++j) { acc[ai][bj][m][0][j] *= a0[j] * frcp(b0[j]); acc[ai][bj][m][1][j] *= a1[j] * frcp(b1[j]); }
                    } else {
                        const f32x4 t0 = b0 * acc[ai][bj][m][0], t1 = b1 * acc[ai][bj][m][1];
                        u32x4 w; w[0] = pk2(t0[0], t0[1]); w[1] = pk2(t0[2], t0[3]); w[2] = pk2(t1[0], t1[1]); w[3] = pk2(t1[2], t1[3]);
                        *(u32x4*)(MB + o) = w;
                    }
                }
            }
    }
};

#define XB_TMO      128
#define XB_XCNT(j)  (256  + 64 * (j))
#define XB_XSUB(j)  (1280 + 64 * (j))
#define XB_XGEN(j)  (2304 + 64 * (j))
#define XB_TOP      3328
#define XB_TOPGEN   3392
#define XCD_BAR_WORDS 3456
#define XB_SPIN_CAP (1u << 18)

__device__ __forceinline__ unsigned xb_ld(unsigned* p)              { return __hip_atomic_load(p, __ATOMIC_RELAXED, __HIP_MEMORY_SCOPE_AGENT); }
__device__ __forceinline__ unsigned xb_add(unsigned* p, unsigned v) { return __hip_atomic_fetch_add(p, v, __ATOMIC_RELAXED, __HIP_MEMORY_SCOPE_AGENT); }
__device__ __forceinline__ unsigned xb_xcc_id() { return (unsigned)__builtin_amdgcn_s_getreg((3 << 11) | 20) & 0xFu; }
#define XB_SPIN(cond, bar) do { unsigned _sp = 0; while (cond) { __builtin_amdgcn_s_sleep(1); \
    if ((++_sp & 255u) == 0u) { if (xb_ld(&(bar)[XB_TMO])) break; if (_sp > XB_SPIN_CAP) { atomicAdd(&(bar)[XB_TMO], 1u); break; } } } } while (0)

struct XcdBarrier {
    unsigned* bar; unsigned x;
    volatile LAS unsigned* st;
};

__device__ __forceinline__ XcdBarrier xcd_barrier_post(unsigned* bar, volatile LAS unsigned* st) {
    XcdBarrier b; b.bar = bar; b.x = xb_xcc_id(); b.st = st;
    if (threadIdx.x == 0) (void)xb_add(&bar[XB_XCNT(b.x)], 1u);
    return b;
}
__device__ __forceinline__ void xcd_barrier_complete(unsigned* bar, unsigned x, unsigned& nloc, unsigned& nx) {
    const unsigned G = gridDim.x * gridDim.y * gridDim.z;
    unsigned sum, cnt, mine, sp = 0u;
    for (;;) {
        sum = 0u; cnt = 0u; mine = 0u;
#pragma unroll
        for (unsigned j = 0; j < 16; ++j) { const unsigned c = xb_ld(&bar[XB_XCNT(j)]); sum += c; cnt += (c > 0u) ? 1u : 0u; mine = (j == x) ? c : mine; }
        if (sum == G) break;
        __builtin_amdgcn_s_sleep(1);
        if ((++sp & 255u) == 0u) { if (xb_ld(&bar[XB_TMO])) break; if (sp > XB_SPIN_CAP) { atomicAdd(&bar[XB_TMO], 1u); break; } }
    }
    nloc = mine > 0u ? mine : 1u; nx = cnt > 0u ? cnt : 1u;
}

__device__ __forceinline__ void xcd_barrier(const XcdBarrier& b) {
    asm volatile("s_waitcnt vmcnt(0)" ::: "memory");
    __syncthreads();
    if (threadIdx.x == 0) {
        unsigned* bar = b.bar;
        __builtin_amdgcn_s_waitcnt(0);
        unsigned nloc = b.st[0], nx = b.st[1];
        if (nloc == 0u) { xcd_barrier_complete(bar, b.x, nloc, nx); b.st[0] = nloc; b.st[1] = nx; }
        const unsigned old = xb_add(&bar[XB_XSUB(b.x)], 1u);
        const unsigned gen = old / nloc;
        if (old + 1u == (gen + 1u) * nloc) {
            __builtin_amdgcn_fence(__ATOMIC_RELEASE, "agent");
            asm volatile("s_waitcnt vmcnt(0)" ::: "memory");
            const unsigned og = xb_add(&bar[XB_TOP], 1u);
            const unsigned tg = og / nx;
            if (og + 1u == (tg + 1u) * nx) xb_add(&bar[XB_TOPGEN], 1u);
            else XB_SPIN(xb_ld(&bar[XB_TOPGEN]) == tg, bar);
            __builtin_amdgcn_fence(__ATOMIC_ACQUIRE, "agent");
            xb_add(&bar[XB_XGEN(b.x)], 1u);
            asm volatile("s_waitcnt vmcnt(0)" ::: "memory");
        } else {
            XB_SPIN(xb_ld(&bar[XB_XGEN(b.x)]) == gen, bar);
            __builtin_amdgcn_fence(__ATOMIC_ACQUIRE, "agent");
            asm volatile("s_waitcnt vmcnt(0)" ::: "memory");
        }
    }
    __syncthreads();
}


struct Frame;
struct Frame {
    LAS unsigned char* lds;
    int tid, lane, wave, G, bid, z;
    unsigned char* ws;
};
__device__ __forceinline__ void refresh(Frame& F);
#define GIN(i) ((const float*)(GAS const float*)(unsigned long long)A.in[(i) + F.z])
#define WSF(off) ((float*)(F.ws + (off)))
#define WSB(off) ((bf16_t*)(F.ws + (off)))

__device__ __forceinline__ void refresh(Frame& F) { int t = threadIdx.x; asm volatile("" : "+v"(t)); F.tid = t; F.lane = t & 63; F.wave = __builtin_amdgcn_readfirstlane(t >> 6); }
__device__ __forceinline__ int perm32(int rho) { const int n = rho >> 4, i = rho & 15; return 8 * (i >> 2) + 4 * n + (i & 3); }
__device__ __forceinline__ int srccol(int kind, int np) {
    if (kind == 1) { const int t = np >> 8, bj = (np >> 7) & 1, wc = (np >> 5) & 3; return bj * FH + 128 * t + 32 * wc + perm32(np & 31); }
    if (kind == 2 && np < 1024) { const int seg = np >> 9, r = np & 511, G = r >> 5, h = G >> 1, s = G & 1, n = (r >> 4) & 1, i = r & 15; return seg * 512 + h * 64 + 32 * n + 16 * s + i; }
    if ((kind == 2 && np >= 2048) || kind == 3) return (np & ~31) + perm32(np & 31);
    return np;
}
struct CvtMat { const float* W; bf16_t* Bt; int K, N, kind; };
__device__ __forceinline__ void cvt_pick(const Args& A, const Frame& F, int l, int it, CvtMat& m, int& tt) {
    constexpr int T_GU = 16 * 44, T_D = 44 * 8, T_IN = 16 * 56, T_SQ = 16 * 8;
    constexpr int O1 = T_GU, O2 = O1 + T_D, O3 = O2 + T_GU, O4 = O3 + T_D, O5 = O4 + T_IN, O6 = O5 + T_SQ, O7 = O6 + T_SQ;
    const int sel = (it >= O1) + (it >= O2) + (it >= O3) + (it >= O4) + (it >= O5) + (it >= O6) + (it >= O7);
    const int inidx = sel == 0 ? 7 : sel == 1 ? 8 : sel == 2 ? 9 : sel == 3 ? 10 : sel == 4 ? 11 : sel == 5 ? 13 : sel == 6 ? 19 : 20;
    const size_t per_layer = (sel == 0 || sel == 2) ? (size_t)D * 2 * FH : (sel == 1 || sel == 3) ? (size_t)FH * D : sel == 4 ? (size_t)D * PW : (size_t)D * D;
    const size_t woff = sel == 0 ? WS_WGU1 : sel == 1 ? WS_WD1 : sel == 2 ? WS_WGU2 : sel == 3 ? WS_WD2 : sel == 4 ? WS_WIN : sel == 5 ? WS_WRO : sel == 6 ? WS_WLO : WS_WOUT;
    m.W = GIN(inidx) + (size_t)l * per_layer; m.Bt = WSB(woff);
    m.K = (sel == 1 || sel == 3) ? FH : D; m.N = (sel == 0 || sel == 2) ? 2 * FH : (sel == 4 ? PW : D); m.kind = (sel == 0 || sel == 2) ? 1 : (sel == 4 ? 2 : 3);
    tt = it - (sel == 0 ? 0 : sel == 1 ? O1 : sel == 2 ? O2 : sel == 3 ? O3 : sel == 4 ? O4 : sel == 5 ? O5 : sel == 6 ? O6 : O7);
}
__device__ __forceinline__ void cvt_load(const Frame& F, const CvtMat& m, int tt, f32x4 (&v)[4]) {
    const int nb = m.N >> 7, kb = tt / nb, nbk = tt - kb * nb, k0 = kb * 64, n0 = nbk * 128;
    const int src = srccol(m.kind, n0 + (F.tid & 31) * 4);
#pragma unroll
    for (int i = 0; i < 4; ++i) v[i] = *(const f32x4*)(m.W + (size_t)(k0 + (F.tid >> 5) + 16 * i) * m.N + src);
}
__device__ __forceinline__ void cvt_store(const Frame& F, const CvtMat& m, int tt, const f32x4 (&v)[4]) {
    LAS float* tile = (LAS float*)F.lds;
    const int nb = m.N >> 7, kb = tt / nb, nbk = tt - kb * nb, k0 = kb * 64, n0 = nbk * 128;
    const int tid = F.tid;
#pragma unroll
    for (int i = 0; i < 4; ++i) {
        const int kk = (tid >> 5) + 16 * i, nn = (tid & 31) * 4;
        tile[kk * 129 + nn] = v[i][0]; tile[kk * 129 + nn + 1] = v[i][1]; tile[kk * 129 + nn + 2] = v[i][2]; tile[kk * 129 + nn + 3] = v[i][3];
    }
    __syncthreads();
    {
        const int n = tid >> 2, ks = (tid & 3) * 16;
        u32x4 o0, o1;
#pragma unroll
        for (int i = 0; i < 4; ++i) o0[i] = pk2(tile[(ks + 2 * i) * 129 + n], tile[(ks + 2 * i + 1) * 129 + n]);
#pragma unroll
        for (int i = 0; i < 4; ++i) o1[i] = pk2(tile[(ks + 8 + 2 * i) * 129 + n], tile[(ks + 8 + 2 * i + 1) * 129 + n]);
        bf16_t* dst = m.Bt + (size_t)(n0 + n) * m.K + k0 + ks;
        *(u32x4*)dst = o0; *(u32x4*)(dst + 8) = o1;
    }
    __syncthreads();
}
__device__ __forceinline__ void convert_layer(const Args& A, Frame& F, int l) {
    refresh(F);
    constexpr int NT = 2 * 16 * 44 + 2 * 44 * 8 + 16 * 56 + 3 * 16 * 8;
    const int nmy = (NT - F.bid + F.G - 1) / F.G;
    f32x4 v[4];
    { CvtMat m; int tt; cvt_pick(A, F, l, F.bid, m, tt); cvt_load(F, m, tt, v); }
    for (int j = 0; j < nmy; ++j) {
        const int it = F.bid + j * F.G, itn = (j + 1 < nmy) ? it + F.G : it;
        f32x4 vn[4];
        { CvtMat mn; int ttn; cvt_pick(A, F, l, itn, mn, ttn); cvt_load(F, mn, ttn, vn); }
        { CvtMat m; int tt; cvt_pick(A, F, l, it, m, tt); cvt_store(F, m, tt, v); }
#pragma unroll
        for (int i = 0; i < 4; ++i) v[i] = vn[i];
    }
}

__device__ __forceinline__ void mods_phase(const Args& A, Frame& F) {
    refresh(F);
    LAS float* sv = (LAS float*)F.lds;
    LAS float* red = sv + 9 * 1024;
    for (int e = F.tid; e < 9 * 1024; e += NTHREADS) { const int r = e >> 10, k = e & 1023; const float c = r < 8 ? GIN(1)[r * D + k] : GIN(3)[k]; sv[e] = siluf_(c); }
    __syncthreads();
    const int col = F.tid & 127, kq = F.tid >> 7;
    for (int it = F.bid; it < NL * 72; it += F.G) {
        const int l = it / 72, cgp = it - l * 72, n = cgp * 128 + col;
        const float* wp = GIN(4) + (size_t)l * D * NMOD + n;
        float a[9];
#pragma unroll
        for (int r = 0; r < 9; ++r) a[r] = 0.f;
        for (int k0 = kq * 256; k0 < kq * 256 + 256; k0 += 16) {
            float w[16];
#pragma unroll
            for (int j = 0; j < 16; ++j) w[j] = wp[(size_t)(k0 + j) * NMOD];
#pragma unroll
            for (int r = 0; r < 9; ++r) {
#pragma unroll
                for (int j4 = 0; j4 < 4; ++j4) {
                    const f32x4 sv4 = *(const LAS f32x4*)(sv + r * 1024 + k0 + 4 * j4);
                    a[r] += sv4[0] * w[4 * j4] + sv4[1] * w[4 * j4 + 1] + sv4[2] * w[4 * j4 + 2] + sv4[3] * w[4 * j4 + 3];
                }
            }
        }
#pragma unroll
        for (int r = 0; r < 9; ++r) red[(kq * 9 + r) * 128 + col] = a[r];
        __syncthreads();
        for (int e = F.tid; e < 9 * 128; e += NTHREADS) {
            const int r = e >> 7, c2 = e & 127, n2 = cgp * 128 + c2;
            const float s = red[(0 * 9 + r) * 128 + c2] + red[(1 * 9 + r) * 128 + c2] + red[(2 * 9 + r) * 128 + c2] + red[(3 * 9 + r) * 128 + c2];
            WSF(WS_MODS)[(size_t)(l * 9 + r) * NMOD + n2] = s + GIN(5)[(size_t)l * NMOD + n2];
        }
        __syncthreads();
    }
}
__device__ __forceinline__ void init_phase(const Args& A, Frame& F) {
    refresh(F);
    const size_t nunits = (size_t)MROWS * D / 4;
    for (size_t uidx = (size_t)F.bid * NTHREADS + F.tid; uidx < nunits; uidx += (size_t)F.G * NTHREADS) {
        const size_t row = uidx >> 8; const int c4 = (int)(uidx & 255) * 4;
        const int b = (int)(row / TB), p = (int)(row - (size_t)b * TB);
        const float* src = p < CTXL ? GIN(2) + ((size_t)b * CTXL + p) * D + c4 : GIN(0) + ((size_t)b * SEQ + (p - CTXL)) * D + c4;
        { const f32x4 xv = *(const f32x4*)src; u32x2 o; o.x = pk2(xv[0], xv[1]); o.y = pk2(xv[2], xv[3]); *(u32x2*)(WSB(WS_R) + row * D + c4) = o; }
    }
    for (int e = F.bid * NTHREADS + F.tid; e < SEQ * 32; e += F.G * NTHREADS) {
        const int t = e >> 5, j = e & 31, f = j & 15;
        const float pos = j < 16 ? (float)(t >> 6) : (float)(t & 63);
        const float inv = powf(10000.f, -(float)f / 16.f);
        float s, c; sincosf(pos * inv, &s, &c);
        WSF(WS_ROPE)[e] = c; WSF(WS_ROPE)[SEQ * 32 + e] = s;
    }
}

__device__ __forceinline__ void norm_phase(const Args& A, Frame& F, int l, int s, bool latonly, bool tailsum) {
    refresh(F);
    const float* g = GIN(6) + (size_t)(l * 3 + s) * D;
    for (int row = F.bid * 8 + F.wave; row < MROWS; row += F.G * 8) {
        const int b = row / TB, p = row - b * TB, mr = p < CTXL ? 8 : b;
        if (latonly && p < CTXL) continue;
        const u32x2* xr = (const u32x2*)(WSB(WS_R) + (size_t)row * D) + F.lane;
        f32x4 v[4]; float ss = 0.f;
#pragma unroll
        for (int j = 0; j < 4; ++j) { const u32x2 xv = xr[64 * j]; v[j][0] = bflo(xv.x); v[j][1] = bfhi(xv.x); v[j][2] = bflo(xv.y); v[j][3] = bfhi(xv.y); }
        if (tailsum && row >= 16384) {
#pragma unroll
            for (int sp = 0; sp < 8; ++sp) {
                const u32x2* pr = (const u32x2*)(WSB(WS_PART) + ((size_t)sp * 2048 + (row - 16384)) * D) + F.lane;
#pragma unroll
                for (int j = 0; j < 4; ++j) { const u32x2 pv = pr[64 * j]; v[j][0] += bflo(pv.x); v[j][1] += bfhi(pv.x); v[j][2] += bflo(pv.y); v[j][3] += bfhi(pv.y); }
            }
            u32x2* xw = (u32x2*)(WSB(WS_R) + (size_t)row * D) + F.lane;
#pragma unroll
            for (int j = 0; j < 4; ++j) { u32x2 o; o.x = pk2(v[j][0], v[j][1]); o.y = pk2(v[j][2], v[j][3]); xw[64 * j] = o; v[j][0] = bflo(o.x); v[j][1] = bfhi(o.x); v[j][2] = bflo(o.y); v[j][3] = bfhi(o.y); }
        }
#pragma unroll
        for (int j = 0; j < 4; ++j) ss += (v[j][0] * v[j][0] + v[j][1] * v[j][1]) + (v[j][2] * v[j][2] + v[j][3] * v[j][3]);
        const float rstd = rsqrtf(wave_sum(ss) * (1.f / D) + EPS);
        const float* mp = WSF(WS_MODS) + (size_t)(l * 9 + mr) * NMOD + (size_t)(3 * s) * D;
        u32x2* o8 = (u32x2*)(WSB(WS_AN) + (size_t)row * D) + F.lane;
#pragma unroll
        for (int j = 0; j < 4; ++j) {
            const int col = 4 * (F.lane + 64 * j);
            const f32x4 gv = *(const f32x4*)(g + col), sh = *(const f32x4*)(mp + col), sc = *(const f32x4*)(mp + D + col);
            const f32x4 y = (v[j] * rstd * gv) * (sc + 1.f) + sh;
            u32x2 o; o.x = pk2(y[0], y[1]); o.y = pk2(y[2], y[3]);
            o8[64 * j] = o;
        }
    }
}
__device__ __forceinline__ void final_phase(const Args& A, Frame& F) {
    refresh(F);
    const float* g = GIN(21);
    for (int r = F.bid * 8 + F.wave; r < NB * SEQ; r += F.G * 8) {
        const int b = r >> 11, t = r & 2047;
        const u32x2* xr = (const u32x2*)(WSB(WS_R) + ((size_t)b * TB + CTXL + t) * D) + F.lane;
        f32x4 v[4]; float ss = 0.f;
#pragma unroll
        for (int j = 0; j < 4; ++j) { const u32x2 xv = xr[64 * j]; v[j][0] = bflo(xv.x); v[j][1] = bfhi(xv.x); v[j][2] = bflo(xv.y); v[j][3] = bfhi(xv.y); ss += (v[j][0] * v[j][0] + v[j][1] * v[j][1]) + (v[j][2] * v[j][2] + v[j][3] * v[j][3]); }
        const float rstd = rsqrtf(wave_sum(ss) * (1.f / D) + EPS);
        f32x4* o = (f32x4*)((float*)(GAS float*)(unsigned long long)A.out + (size_t)r * D) + F.lane;
#pragma unroll
        for (int j = 0; j < 4; ++j) { const f32x4 gv = *(const f32x4*)(g + 4 * (F.lane + 64 * j)); o[64 * j] = v[j] * rstd * gv; }
    }
}

__device__ __forceinline__ float log2_gamma(const Args& A, const Frame& F, int l, int dir, int h) {
    const float x = GIN(12)[(l * 2 + dir) * NH + h];
    return -softplusf_(-x) * 1.4426950408889634f;
}

__device__ __forceinline__ void ret_state_item(const Args& A, Frame& F, int l, int it) {
    refresh(F);
    const int dvh = it & 1, dir = (it >> 1) & 1, h = (it >> 2) & 7, b = it >> 5;
    const int lane = F.lane, fr = lane & 15, fq = lane >> 4, w = F.wave, dvt = w & 3, dkh = w >> 2;
    const float l2g = log2_gamma(A, F, l, dir, h);
    const float cdec = exp2f(128.f * l2g);
    float dec[4][8];
#pragma unroll
    for (int ks = 0; ks < 4; ++ks)
#pragma unroll
        for (int s = 0; s < 8; ++s) { const int a = 32 * ks + 8 * fq + s; dec[ks][s] = exp2f(l2g * (float)(dir ? a : 127 - a)); }
    const int dvrow = 64 * dvh + 16 * dvt + fr;
    const bf16_t* kbase = WSB(WS_KT) + ((size_t)(b * NH + h) * DK + 32 * dkh + fr) * TB;
    const bf16_t* vbase = WSB(WS_VT) + ((size_t)(b * NH + h) * DV + dvrow) * TB;
    f32x4 acc[2];
    acc[0] = (f32x4){0.f, 0.f, 0.f, 0.f}; acc[1] = acc[0];
    bf16x8 ka[4][2], va[4], kb2[4][2], vb2[4];
#define ST_MC(step_) (dir == 0 ? (step_) : ((step_) < 2 ? 1 - (step_) : 19 - (step_)))
#define ST_LOAD(KS, VS, mc_) do { const int _p0 = 128 * (mc_); _Pragma("unroll") for (int ks = 0; ks < 4; ++ks) { VS[ks] = *(const bf16x8*)(vbase + _p0 + 32 * ks + 8 * fq); \
        _Pragma("unroll") for (int t = 0; t < 2; ++t) KS[ks][t] = *(const bf16x8*)(kbase + (size_t)(16 * t) * TB + _p0 + 32 * ks + 8 * fq); } } while (0)
#define ST_STORE(mc_) do { bf16_t* stp = WSB(WS_ST) + ((((size_t)(b * NH + h) * 2 + dir) * NCH + (mc_)) * DV + dvrow) * DK + 32 * dkh + 4 * fq; \
        _Pragma("unroll") for (int t = 0; t < 2; ++t) { u32x2 o; o.x = pk2(acc[t][0], acc[t][1]); o.y = pk2(acc[t][2], acc[t][3]); *(u32x2*)(stp + 16 * t) = o; } } while (0)
#define ST_COMPUTE(KS, VS) do { acc[0] *= cdec; acc[1] *= cdec; _Pragma("unroll") for (int ks = 0; ks < 4; ++ks) { const bf16x8 bv = scale8(VS[ks], dec[ks]); \
        _Pragma("unroll") for (int t = 0; t < 2; ++t) acc[t] = __builtin_amdgcn_mfma_f32_16x16x32_bf16(KS[ks][t], bv, acc[t], 0, 0, 0); } } while (0)
    ST_LOAD(ka, va, ST_MC(0));
    for (int s2 = 0; s2 < NCH; s2 += 2) {
        ST_STORE(ST_MC(s2));
        { const int sn = s2 + 1 < NCH - 1 ? s2 + 1 : NCH - 2; ST_LOAD(kb2, vb2, ST_MC(sn)); }
        ST_COMPUTE(ka, va);
        ST_STORE(ST_MC(s2 + 1));
        if (s2 + 1 == NCH - 1) break;
        { const int sn = s2 + 2 < NCH - 1 ? s2 + 2 : NCH - 2; ST_LOAD(ka, va, ST_MC(sn)); }
        ST_COMPUTE(kb2, vb2);
    }
#undef ST_MC
#undef ST_LOAD
#undef ST_STORE
#undef ST_COMPUTE
}

__device__ __forceinline__ void lru_item(const Args& A, Frame& F, int l, int it) {
    refresh(F);
    const int blk = it & 15, dir = (it >> 4) & 1, b = it >> 5;
    const int tid = F.tid, lane = F.lane, fr = lane & 15, fq = lane >> 4, w = F.wave;
    LAS float* us = (LAS float*)F.lds;
    LAS float* as = us + 128 * 64;
    LAS bf16_t* ub = (LAS bf16_t*)(F.lds + 65536);
    LAS bf16_t* wgs = (LAS bf16_t*)(F.lds + 65536 + 18432);
    LAS float* segA = (LAS float*)(F.lds + 65536 + 2 * 18432);
    LAS float* segB = segA + 512;
    LAS float* hcar = segA + 2048;
    __syncthreads();
    {
        const float* gw = GIN(16) + ((size_t)(l * 2 + dir) * 2) * 16 * 64 * 64;
        for (int e = tid; e < 2 * 64 * 64; e += NTHREADS) {
            const int g = e >> 12, k = (e >> 6) & 63, j = e & 63;
            wgs[(g * 64 + j) * 72 + k] = f2bf(gw[((size_t)(g * 16 + blk) * 64 + k) * 64 + j]);
        }
        if (tid < 128) hcar[tid] = 0.f;
    }
    float bgr[4], bgi[4], spl[4];
#pragma unroll
    for (int nt = 0; nt < 4; ++nt) {
        const int ch = blk * 64 + 16 * nt + fr;
        bgr[nt] = GIN(17)[((size_t)(l * 2 + dir) * 2 + 0) * D + ch];
        bgi[nt] = GIN(17)[((size_t)(l * 2 + dir) * 2 + 1) * D + ch];
        spl[nt] = -8.f * 1.4426950408889634f * softplusf_(-GIN(18)[(size_t)(l * 2 + dir) * D + ch]);
    }
    const int c4 = (tid & 15) * 4, chg = blk * 64 + c4;
    f32x4 cw[4];
#pragma unroll
    for (int j = 0; j < 4; ++j) cw[j] = *(const f32x4*)(GIN(14) + (size_t)(l * 4 + j) * D + chg);
    const f32x4 cb = *(const f32x4*)(GIN(15) + (size_t)l * D + chg);
    const bf16_t* lx = WSB(WS_LX) + (size_t)b * TB * D + chg;
    bf16_t* hout = (dir ? WSB(WS_HB) : WSB(WS_HF)) + (size_t)b * TB * D + blk * 64;
    __syncthreads();
    const int g4 = tid >> 4;
    u32x2 xr[7];
    {
        const int pb0 = dir == 0 ? 0 : 255;
        const int pmin = dir == 0 ? pb0 + 4 * g4 : pb0 - 4 * g4 - 3;
#pragma unroll
        for (int e = 0; e < 7; ++e) { const int q = pmin - 2 + e; const int qc = q < 0 ? 0 : (q >= CTXL ? CTXL - 1 : q); xr[e] = *(const u32x2*)(lx + (size_t)qc * D); }
    }
    for (int sc = 0; sc < NCH; ++sc) {
        const int lo = sc < 2 ? 0 : CTXL, hi = sc < 2 ? CTXL : TB;
        const int pbase = dir == 0 ? 128 * sc : (sc < 2 ? 255 - 128 * sc : 2303 - 128 * (sc - 2));
        {
            const int pmin = dir == 0 ? pbase + 4 * g4 : pbase - 4 * g4 - 3;
            f32x4 xw[7];
#pragma unroll
            for (int e = 0; e < 7; ++e) {
                const int q = pmin - 2 + e;
                const float msk = (q >= lo && q < hi) ? 1.f : 0.f;
                xw[e][0] = bflo(xr[e].x) * msk; xw[e][1] = bfhi(xr[e].x) * msk; xw[e][2] = bflo(xr[e].y) * msk; xw[e][3] = bfhi(xr[e].y) * msk;
            }
#pragma unroll
            for (int m = 0; m < 4; ++m) {
                const f32x4 a = cb + cw[0] * xw[m] + cw[1] * xw[m + 1] + cw[2] * xw[m + 2] + cw[3] * xw[m + 3];
                const int si = dir == 0 ? 4 * g4 + m : 4 * g4 + 3 - m;
                *(LAS f32x4*)(us + si * 64 + c4) = a;
                u32x2 o; o.x = pk2(a[0], a[1]); o.y = pk2(a[2], a[3]);
                *(LAS u32x2*)(ub + si * 72 + c4) = o;
            }
        }
        {
            const int sn = sc + 1 < NCH ? sc + 1 : sc;
            const int lon = sn < 2 ? 0 : CTXL, hin = sn < 2 ? CTXL : TB;
            const int pbn = dir == 0 ? 128 * sn : (sn < 2 ? 255 - 128 * sn : 2303 - 128 * (sn - 2));
            const int pminn = dir == 0 ? pbn + 4 * g4 : pbn - 4 * g4 - 3;
#pragma unroll
            for (int e = 0; e < 7; ++e) { const int q = pminn - 2 + e; const int qc = q < lon ? lon : (q >= hin ? hin - 1 : q); xr[e] = *(const u32x2*)(lx + (size_t)qc * D); }
        }
        __builtin_amdgcn_fence(__ATOMIC_RELEASE, "workgroup"); __builtin_amdgcn_wave_barrier(); __builtin_amdgcn_fence(__ATOMIC_ACQUIRE, "workgroup");
        {
            bf16x8 af[2];
#pragma unroll
            for (int ks = 0; ks < 2; ++ks) af[ks] = *(const LAS bf16x8*)(ub + (16 * w + fr) * 72 + 32 * ks + 8 * fq);
            f32x4 gacc[8];
#pragma unroll
            for (int nt = 0; nt < 8; ++nt) {
                gacc[nt] = (f32x4){0.f, 0.f, 0.f, 0.f};
#pragma unroll
                for (int ks = 0; ks < 2; ++ks) {
                    const bf16x8 bfm = *(const LAS bf16x8*)(wgs + (16 * nt + fr) * 72 + 32 * ks + 8 * fq);
                    gacc[nt] = __builtin_amdgcn_mfma_f32_16x16x32_bf16(af[ks], bfm, gacc[nt], 0, 0, 0);
                }
            }
#pragma unroll
            for (int nt = 0; nt < 4; ++nt)
#pragma unroll
                for (int r = 0; r < 4; ++r) {
                    const int si = 16 * w + 4 * fq + r, ch = 16 * nt + fr;
                    const float d0 = 1.f + __builtin_amdgcn_exp2f(fminf((gacc[nt][r] + bgr[nt]) * -1.4426950408889634f, 60.f));
                    const float d1 = 1.f + __builtin_amdgcn_exp2f(fminf((gacc[nt + 4][r] + bgi[nt]) * -1.4426950408889634f, 60.f));
                    const float rr = frcp(d0 * d1);
                    const float rg = rr * d1, ig = rr * d0;
                    const float av = __builtin_amdgcn_exp2f(rg * spl[nt]);
                    const float mult = __builtin_amdgcn_sqrtf(fmaxf(1.f - av * av, 0.f));
                    const float uu = us[si * 64 + ch];
                    as[si * 64 + ch] = av;
                    us[si * 64 + ch] = mult * ig * uu;
                }
        }
        __builtin_amdgcn_fence(__ATOMIC_RELEASE, "workgroup"); __builtin_amdgcn_wave_barrier(); __builtin_amdgcn_fence(__ATOMIC_ACQUIRE, "workgroup");
        {
            const int ch = tid & 63, seg = tid >> 6;
            float A = 1.f, Bv = 0.f;
#pragma unroll
            for (int i = 0; i < 16; ++i) { const int si = 16 * seg + i; const float a = as[si * 64 + ch], bb = us[si * 64 + ch]; A *= a; Bv = a * Bv + bb; }
            LAS float* sA = segA + (sc & 1) * 1024; LAS float* sB = segB + (sc & 1) * 1024;
            sA[seg * 64 + ch] = A; sB[seg * 64 + ch] = Bv;
            __syncthreads();
            float hv = hcar[(sc & 1) * 64 + ch];
            for (int s = 0; s < seg; ++s) hv = sA[s * 64 + ch] * hv + sB[s * 64 + ch];
#pragma unroll
            for (int i = 0; i < 16; ++i) {
                const int si = 16 * seg + i; const float a = as[si * 64 + ch], bb = us[si * 64 + ch];
                hv = a * hv + bb;
                const int p = dir == 0 ? pbase + si : pbase - si;
                hout[(size_t)p * D + ch] = f2bf(hv);
            }
            if (seg == 7) hcar[((sc + 1) & 1) * 64 + ch] = hv;
            __builtin_amdgcn_fence(__ATOMIC_RELEASE, "workgroup"); __builtin_amdgcn_wave_barrier(); __builtin_amdgcn_fence(__ATOMIC_ACQUIRE, "workgroup");
        }
    }
    __syncthreads();
}

struct RetPre { u32x4 k[2], sf[2], sb[2], vt[4]; };
__device__ __forceinline__ void ret_prefetch(const Frame& F, int it, int nchu, RetPre& P) {
    const int bh = it / nchu, mc = it - bh * nchu + (NCH - nchu), h = bh & 7, b = bh >> 3;
    const int tid = F.tid;
    const size_t rowbase = (size_t)b * TB + 128 * mc;
#pragma unroll
    for (int i = 0; i < 2; ++i) {
        const int u = tid + i * NTHREADS, r = u >> 3, c8 = (u & 7) * 8;
        P.k[i] = *(const u32x4*)(WSB(WS_KN) + (rowbase + r) * 512 + h * 64 + c8);
        P.sf[i] = *(const u32x4*)(WSB(WS_ST) + ((((size_t)(b * NH + h) * 2 + 0) * NCH + mc) * DV + r) * DK + c8);
        P.sb[i] = *(const u32x4*)(WSB(WS_ST) + ((((size_t)(b * NH + h) * 2 + 1) * NCH + mc) * DV + r) * DK + c8);
    }
#pragma unroll
    for (int i = 0; i < 4; ++i) {
        const int u = tid + i * NTHREADS, r = u >> 4, c8 = (u & 15) * 8;
        P.vt[i] = *(const u32x4*)(WSB(WS_VT) + ((size_t)(b * NH + h) * DV + r) * TB + 128 * mc + c8);
    }
}
__device__ __forceinline__ void ret_out_phase(const Args& A, Frame& F, int l, bool lastl, bf16_t* ARET, bf16_t* ALRU) {
    refresh(F);
    const int tid = F.tid, lane = F.lane, fr = lane & 15, fq = lane >> 4, w = F.wave;
    LAS bf16_t* ks_ = (LAS bf16_t*)F.lds;
    LAS bf16_t* vts = (LAS bf16_t*)(F.lds + 18432);
    LAS bf16_t* sfs = (LAS bf16_t*)(F.lds + 18432 + 34816);
    LAS bf16_t* sbs = (LAS bf16_t*)(F.lds + 2 * 18432 + 34816);
    LAS bf16_t* os = (LAS bf16_t*)(F.lds + 3 * 18432 + 34816);
    const int NCHU = lastl ? NCH - 2 : NCH;
    const int NIT = NB * NH * NCHU;
    const int nmy = (NIT - F.bid + F.G - 1) / F.G;
    RetPre P;
    ret_prefetch(F, F.bid, NCHU, P);
    for (int jx = 0; jx < nmy; ++jx) {
        const int it = F.bid + jx * F.G, itn = (jx + 1 < nmy) ? it + F.G : it;
        const int bh = it / NCHU, mc = it - bh * NCHU + (NCH - NCHU), h = bh & 7, b = bh >> 3;
        const size_t rowbase = (size_t)b * TB + 128 * mc;
        __syncthreads();
#pragma unroll
        for (int i = 0; i < 2; ++i) {
            const int u = tid + i * NTHREADS, r = u >> 3, c8 = (u & 7) * 8;
            *(LAS u32x4*)(ks_ + r * 72 + c8) = P.k[i]; *(LAS u32x4*)(sfs + r * 72 + c8) = P.sf[i]; *(LAS u32x4*)(sbs + r * 72 + c8) = P.sb[i];
        }
#pragma unroll
        for (int i = 0; i < 4; ++i) { const int u = tid + i * NTHREADS, r = u >> 4, c8 = (u & 15) * 8; *(LAS u32x4*)(vts + r * 136 + c8) = P.vt[i]; }
        bf16x8 qf[2];
#pragma unroll
        for (int ks = 0; ks < 2; ++ks) qf[ks] = *(const bf16x8*)(WSB(WS_Q) + (rowbase + 16 * w + fr) * 512 + h * 64 + 32 * ks + 8 * fq);
        __syncthreads();
        ret_prefetch(F, itn, NCHU, P);
        const float l2f = log2_gamma(A, F, l, 0, h), l2b = log2_gamma(A, F, l, 1, h);
        bf16x8 pa[4];
        {
            const int i_loc = 16 * w + fr;
#pragma unroll
            for (int jp = 0; jp < 4; ++jp) {
                f32x4 c0 = (f32x4){0.f, 0.f, 0.f, 0.f}, c1 = c0;
#pragma unroll
                for (int ks = 0; ks < 2; ++ks) {
                    const bf16x8 k0 = *(const LAS bf16x8*)(ks_ + (32 * jp + fr) * 72 + 32 * ks + 8 * fq);
                    const bf16x8 k1 = *(const LAS bf16x8*)(ks_ + (32 * jp + 16 + fr) * 72 + 32 * ks + 8 * fq);
                    c0 = __builtin_amdgcn_mfma_f32_16x16x32_bf16(k0, qf[ks], c0, 0, 0, 0);
                    c1 = __builtin_amdgcn_mfma_f32_16x16x32_bf16(k1, qf[ks], c1, 0, 0, 0);
                }
                float v[8];
#pragma unroll
                for (int r = 0; r < 4; ++r) {
                    const int j0 = 32 * jp + 4 * fq + r, j1 = j0 + 16;
                    const int d0 = i_loc - j0, d1 = i_loc - j1;
                    v[r] = c0[r] * (d0 >= 0 ? exp2f((float)d0 * l2f) : exp2f((float)(-d0) * l2b));
                    v[4 + r] = c1[r] * (d1 >= 0 ? exp2f((float)d1 * l2f) : exp2f((float)(-d1) * l2b));
                }
                u32x4 pv; pv[0] = pk2(v[0], v[1]); pv[1] = pk2(v[2], v[3]); pv[2] = pk2(v[4], v[5]); pv[3] = pk2(v[6], v[7]);
                pa[jp] = __builtin_bit_cast(bf16x8, pv);
            }
        }
        bf16x8 qF[2], qB[2];
        {
            const int il = 16 * w + fr;
            const float sF = exp2f((float)(il + 1) * l2f), sB = exp2f((float)(128 - il) * l2b);
#pragma unroll
            for (int ks = 0; ks < 2; ++ks) { qF[ks] = scale1(qf[ks], sF); qB[ks] = scale1(qf[ks], sB); }
        }
        f32x4 O[8];
#pragma unroll
        for (int dvt = 0; dvt < 8; ++dvt) {
            f32x4 o = (f32x4){0.f, 0.f, 0.f, 0.f};
#pragma unroll
            for (int jp = 0; jp < 4; ++jp) {
                const u32x2 lo = *(const LAS u32x2*)(vts + (16 * dvt + fr) * 136 + 32 * jp + 4 * fq);
                const u32x2 hi = *(const LAS u32x2*)(vts + (16 * dvt + fr) * 136 + 32 * jp + 16 + 4 * fq);
                u32x4 bv; bv[0] = lo.x; bv[1] = lo.y; bv[2] = hi.x; bv[3] = hi.y;
                o = __builtin_amdgcn_mfma_f32_16x16x32_bf16(pa[jp], __builtin_bit_cast(bf16x8, bv), o, 0, 0, 0);
            }
#pragma unroll
            for (int ks = 0; ks < 2; ++ks) {
                const bf16x8 sf = *(const LAS bf16x8*)(sfs + (16 * dvt + fr) * 72 + 32 * ks + 8 * fq);
                const bf16x8 sb = *(const LAS bf16x8*)(sbs + (16 * dvt + fr) * 72 + 32 * ks + 8 * fq);
                o = __builtin_amdgcn_mfma_f32_16x16x32_bf16(qF[ks], sf, o, 0, 0, 0);
                o = __builtin_amdgcn_mfma_f32_16x16x32_bf16(qB[ks], sb, o, 0, 0, 0);
            }
            O[dvt] = o;
            __builtin_amdgcn_sched_barrier(0);
        }
#pragma unroll
        for (int r = 0; r < 4; ++r) {
            float sm = 0.f;
#pragma unroll
            for (int dvt = 0; dvt < 8; ++dvt) sm += O[dvt][r];
            const float mu = sum16(sm) * (1.f / DV);
            float q2 = 0.f;
#pragma unroll
            for (int dvt = 0; dvt < 8; ++dvt) { const float dd = O[dvt][r] - mu; q2 += dd * dd; }
            const float rstd = rsqrtf(sum16(q2) * (1.f / DV) + EPS);
#pragma unroll
            for (int dvt = 0; dvt < 8; ++dvt) os[(16 * w + 4 * fq + r) * 136 + 16 * dvt + fr] = f2bf((O[dvt][r] - mu) * rstd);
        }
        __builtin_amdgcn_fence(__ATOMIC_RELEASE, "workgroup"); __builtin_amdgcn_wave_barrier(); __builtin_amdgcn_fence(__ATOMIC_ACQUIRE, "workgroup");
        {
            const int rr = 16 * w + (lane >> 2), cc = (lane & 3) * 32;
            const size_t go = (rowbase + rr) * D + 128 * h + cc;
#pragma unroll
            for (int i = 0; i < 4; ++i) {
                const u32x4 ov = *(const LAS u32x4*)(os + rr * 136 + cc + 8 * i);
                const u32x4 gv = *(const u32x4*)(WSB(WS_SG) + go + 8 * i);
                u32x4 rv;
#pragma unroll
                for (int e = 0; e < 4; ++e) rv[e] = pk2(bflo(ov[e]) * bflo(gv[e]), bfhi(ov[e]) * bfhi(gv[e]));
                *(u32x4*)(ARET + go + 8 * i) = rv;
            }
        }
#pragma unroll 2
        for (int i = 0; i < 4; ++i) {
            const int u = tid + i * NTHREADS, r = u >> 4, c8 = (u & 15) * 8;
            const size_t o = (rowbase + r) * D + 128 * h + c8;
            const u32x4 hf = *(const u32x4*)(WSB(WS_HF) + o), hb = *(const u32x4*)(WSB(WS_HB) + o), gg = *(const u32x4*)(WSB(WS_GG) + o);
            u32x4 ov;
#pragma unroll
            for (int e = 0; e < 4; ++e) ov[e] = pk2((bflo(hf[e]) + bflo(hb[e])) * bflo(gg[e]), (bfhi(hf[e]) + bfhi(hb[e])) * bfhi(gg[e]));
            *(u32x4*)(ALRU + o) = ov;
        }
    }
    __syncthreads();
}

__global__ void __launch_bounds__(NTHREADS) mega(Args args) {
    extern __shared__ __attribute__((aligned(16))) unsigned char lds_raw[];
    cg::grid_group grid = cg::this_grid();
    Frame F;
    F.lds = (LAS unsigned char*)lds_raw;
    F.tid = threadIdx.x; F.lane = F.tid & 63; F.wave = __builtin_amdgcn_readfirstlane(F.tid >> 6);
    F.G = gridDim.x; F.bid = blockIdx.x;
    volatile LAS unsigned* bst = (volatile LAS unsigned*)(F.lds + LDS_WORK);
    if (F.tid < 4) bst[F.tid] = 0u;
    __syncthreads();
    XcdBarrier xbar = xcd_barrier_post((unsigned*)(args.ws + WS_BAR), bst);
    F.ws = args.ws;
    bf16_t* const ARET = WSB(WS_AN);
    bf16_t* const ALRU = WSB(WS_LX);
    bf16_t* const MB = WSB(WS_SG);

    const int lo = args.ph_lo, hi = args.ph_hi;
    constexpr int NPH = 2 + 12 * NL;
    for (int ph = lo; ph < hi; ++ph) {
        { int z = 0; unsigned long long w = (unsigned long long)args.ws; int bb = (int)blockIdx.x, gg = (int)gridDim.x; asm volatile("" : "+s"(z), "+s"(w), "+s"(bb), "+s"(gg)); F.z = z; F.ws = (unsigned char*)(GAS unsigned char*)w; F.bid = bb; F.G = gg; }
        if (ph == 0) { mods_phase(args, F); init_phase(args, F); convert_layer(args, F, 0); }
        else if (ph == NPH - 1) { final_phase(args, F); }
        else {
            const int l = (ph - 1) / 12, k = (ph - 1) - 12 * l;
            const bool lastl = (l == NL - 1);
            for (int rep = 0; rep < ((PROBE_K >= 0 && k == PROBE_K) ? PROBE_N : 1); ++rep) {
            if (rep > 0) __syncthreads();
            if (k == 0 || k == 3 || k == 9) {
                if (k == 0 && l > 0) convert_layer(args, F, l);
                norm_phase(args, F, l, k == 0 ? 0 : (k == 3 ? 1 : 2), lastl && k == 9, F.G == 256 && !(l == 0 && k == 0) && !(lastl && k == 9));
            } else if (k == 1 || k == 10) {
                const int lat = (lastl && k == 10) ? 1 : 0;
                bf16_t* Bw = k == 1 ? WSB(WS_WGU1) : WSB(WS_WGU2);
                pg8::Gemm g{WSB(WS_AN), WSB(WS_AN), Bw, Bw, D}; pg8::Sched S; S.init(lat ? 64 : 72, 22, F.G, F.bid, 0, lat, 0, D);
                EpiSwiglu E{F.ws}; pg8::build_units(F.lds, S); pg8::gemm_phase(F.lds, g, E);
            } else if (k == 2 || k == 8 || k == 11) {
                const int lat = (lastl && k != 2) ? 1 : 0;
                if (k == 8 && !lat && F.G == 256) {
                    const int row = F.bid * 8 + F.wave;
                    f32x4 v[4];
#pragma unroll
                    for (int j = 0; j < 4; ++j) v[j] = (f32x4){0.f, 0.f, 0.f, 0.f};
#pragma unroll
                    for (int sp = 0; sp < 8; ++sp) {
                        const u32x2* pr = (const u32x2*)(WSB(WS_PART2) + ((size_t)sp * 2048 + row) * D) + F.lane;
#pragma unroll
                        for (int j = 0; j < 4; ++j) { const u32x2 pv = pr[64 * j]; v[j][0] += bflo(pv.x); v[j][1] += bfhi(pv.x); v[j][2] += bflo(pv.y); v[j][3] += bfhi(pv.y); }
                    }
                    u32x2* o8 = (u32x2*)(MB + (size_t)(16384 + row) * D) + F.lane;
#pragma unroll
                    for (int j = 0; j < 4; ++j) { u32x2 o; o.x = pk2(v[j][0], v[j][1]); o.y = pk2(v[j][2], v[j][3]); o8[64 * j] = o; }
                    { XcdBarrier xb = xbar; unsigned* bp = xb.bar; unsigned bx = xb.x; asm volatile("" : "+s"(bp), "+s"(bx)); xb.bar = (unsigned*)(GAS unsigned*)(unsigned long long)bp; xb.x = bx; xcd_barrier(xb); }
                }
                bf16_t* Aop = k == 8 ? MB : WSB(WS_H);
                bf16_t* Bw = k == 2 ? WSB(WS_WD1) : (k == 8 ? WSB(WS_WOUT) : WSB(WS_WD2));
                pg8::Gemm g{Aop, Aop, Bw, Bw, k == 8 ? D : FH}; pg8::Sched S; S.init(lat ? 64 : 72, 4, F.G, F.bid, 0, lat, (!lat && F.G == 256) ? 1 : 0, k == 8 ? D : FH);
                EpiRes E{F.ws, l, k == 2 ? 2 : (k == 8 ? 5 : 8), k == 8 ? 1.0f : 0.5f}; pg8::build_units(F.lds, S); pg8::gemm_phase(F.lds, g, E);
            } else if (k == 4) {
                pg8::Gemm g{WSB(WS_AN), WSB(WS_AN), WSB(WS_WIN), WSB(WS_WIN), D}; pg8::Sched S; S.init(72, 28, F.G, F.bid, 0, 0, 0, D);
                EpiWin E{F.ws}; pg8::build_units(F.lds, S); pg8::gemm_phase(F.lds, g, E);
            } else if (k == 5) {
                for (int it = F.bid; it < 512; it += F.G) { if (it < 256) lru_item(args, F, l, it); else ret_state_item(args, F, l, it - 256); }
            } else if (k == 6) {
                ret_out_phase(args, F, l, lastl, ARET, ALRU);
            } else {
                const int lat = lastl ? 1 : 0;
                pg8::Gemm g{ARET, ALRU, WSB(WS_WRO), WSB(WS_WLO), D}; pg8::Sched S; S.init(lat ? 64 : 72, 4, F.G, F.bid, 1, lat, (!lat && F.G == 256) ? 2 : 0, D);
                EpiMerge E{F.ws}; pg8::build_units(F.lds, S); pg8::gemm_phase(F.lds, g, E);
            }
            }
        }
        if (ph + 1 < hi) { if (args.coop == 0x7fffffff) grid.sync();
            { XcdBarrier xb = xbar; unsigned* bp = xb.bar; unsigned bx = xb.x; asm volatile("" : "+s"(bp), "+s"(bx)); xb.bar = (unsigned*)(GAS unsigned*)(unsigned long long)bp; xb.x = bx; xcd_barrier(xb); } }
    }
}

constexpr int N_PHASES = 2 + 12 * NL;

extern "C" void kernel_launch(void* const* d_in, const int* in_sizes, int n_in, void* d_out, int out_size, void* d_ws, size_t ws_size, hipStream_t stream) {
    static int grid = 0;
    if (grid == 0) {
        if (n_in != 22 || ws_size < WS_END) { fprintf(stderr, "kernel_launch: need 22 inputs and %zu bytes of workspace (got %d, %zu)\n", (size_t)WS_END, n_in, ws_size); grid = -1; return; }
        int dev = 0, cus = 0, per_cu = 0;
        hipGetDevice(&dev);
        hipDeviceGetAttribute(&cus, hipDeviceAttributeMultiprocessorCount, dev);
        if (hipFuncSetAttribute((const void*)mega, hipFuncAttributeMaxDynamicSharedMemorySize, LDS_BYTES) != hipSuccess) { fprintf(stderr, "kernel_launch: hipFuncSetAttribute failed\n"); grid = -1; return; }
        if (hipOccupancyMaxActiveBlocksPerMultiprocessor(&per_cu, (const void*)mega, NTHREADS, LDS_BYTES) != hipSuccess || per_cu < 1) { fprintf(stderr, "kernel_launch: occupancy query says %d\n", per_cu); per_cu = 1; }
        (void)hipGetLastError();
        grid = cus * per_cu;
        if (grid > 256) grid = 256;
    }
    if (grid < 0) return;
    if (hipMemsetAsync(d_ws, 0, 16384, stream) != hipSuccess) { fprintf(stderr, "kernel_launch: memset of barrier words failed\n"); return; }
    Args a{};
    for (int i = 0; i < 22; ++i) a.in[i] = (const float*)d_in[i];
    a.out = (float*)d_out; a.ws = (unsigned char*)d_ws;
#if MK_MULTI
    for (int p = 0; p < N_PHASES; ++p) {
        a.ph_lo = p; a.ph_hi = p + 1; a.coop = 0;
        hipLaunchKernelGGL(mega, dim3(grid), dim3(NTHREADS), LDS_BYTES, stream, a);
    }
#else
    a.ph_lo = 0; a.ph_hi = N_PHASES; a.coop = 1;
    void* kargs[] = {&a};
    hipError_t e = hipLaunchCooperativeKernel((const void*)mega, dim3(grid), dim3(NTHREADS), kargs, LDS_BYTES, stream);
    if (e != hipSuccess) fprintf(stderr, "cooperative launch failed: %s (grid %d)\n", hipGetErrorString(e), grid);
#endif
}
```

```cpp
#include <hip/hip_runtime.h>
#include <hip/hip_cooperative_groups.h>
#include <cstdio>
#include <cstdint>
namespace cg = cooperative_groups;

#ifndef PROBE_K
#define PROBE_K -1
#endif
#ifndef PROBE_N
#define PROBE_N 1
#endif
#ifndef MK_MULTI
#define MK_MULTI 0
#endif

#define LAS __attribute__((address_space(3)))
#define GAS __attribute__((address_space(1)))
typedef unsigned short bf16_t;
typedef short bf16x8 __attribute__((ext_vector_type(8)));
typedef float f32x4 __attribute__((ext_vector_type(4)));
typedef unsigned u32x4 __attribute__((ext_vector_type(4)));
typedef unsigned u32x2 __attribute__((ext_vector_type(2)));

constexpr int D = 1024, NB = 8, SEQ = 2048, CTXL = 256, TB = 2304, MROWS = NB * TB, NL = 4, FH = 2816, PW = 7168;
constexpr int NH = 8, DK = 64, DV = 128, NCH = 18, NMOD = 9 * D;
constexpr float EPS = 1e-6f;
constexpr int NTHREADS = 512;
constexpr int LDS_WORK = 131072;
constexpr int LDS_BYTES = LDS_WORK + 1024;

constexpr size_t al256(size_t x) { return (x + 255) & ~(size_t)255; }
constexpr size_t WS_BAR = 0;
constexpr size_t WS_MODS = 16384;
constexpr size_t WS_ROPE = al256(WS_MODS + (size_t)NL * 9 * NMOD * 4);
constexpr size_t WS_WGU1 = al256(WS_ROPE + (size_t)2 * SEQ * 32 * 4);
constexpr size_t WS_WD1 = WS_WGU1 + (size_t)2 * FH * D * 2;
constexpr size_t WS_WGU2 = WS_WD1 + (size_t)FH * D * 2;
constexpr size_t WS_WD2 = WS_WGU2 + (size_t)2 * FH * D * 2;
constexpr size_t WS_WIN = WS_WD2 + (size_t)FH * D * 2;
constexpr size_t WS_WRO = WS_WIN + (size_t)PW * D * 2;
constexpr size_t WS_WLO = WS_WRO + (size_t)D * D * 2;
constexpr size_t WS_WOUT = WS_WLO + (size_t)D * D * 2;
constexpr size_t WS_R = al256(WS_WOUT + (size_t)D * D * 2);
constexpr size_t WS_AN = WS_R + (size_t)MROWS * D * 4;
constexpr size_t WS_ZONE = WS_AN + (size_t)MROWS * D * 2;
constexpr size_t WS_Q = WS_ZONE;
constexpr size_t WS_KN = WS_Q + (size_t)MROWS * 512 * 2;
constexpr size_t WS_KT = WS_KN + (size_t)MROWS * 512 * 2;
constexpr size_t WS_VT = WS_KT + (size_t)MROWS * 512 * 2;
constexpr size_t WS_SG = WS_VT + (size_t)MROWS * D * 2;
constexpr size_t WS_LX = WS_SG + (size_t)MROWS * D * 2;
constexpr size_t WS_GG = WS_LX + (size_t)MROWS * D * 2;
constexpr size_t WS_GA = WS_GG + (size_t)MROWS * D * 2;
constexpr size_t WS_GB = WS_GA + (size_t)MROWS * D * 2;
constexpr size_t WS_ST = WS_GB + (size_t)MROWS * D * 2;
constexpr size_t WS_HF = WS_ST + (size_t)NB * NH * 2 * NCH * DV * DK * 2;
constexpr size_t WS_HB = WS_HF + (size_t)MROWS * D * 2;
constexpr size_t WS_END = WS_HB + (size_t)MROWS * D * 2;
constexpr size_t WS_PART = WS_LX;
constexpr size_t WS_PART2 = WS_ZONE;
constexpr size_t WS_H = WS_ZONE;
constexpr size_t WS_T = WS_ZONE;
static_assert((size_t)MROWS * FH * 2 <= WS_LX - WS_ZONE, "H overlay must not reach the split-K partials");
static_assert((size_t)8 * 2048 * D * 4 <= WS_GA - WS_LX, "partials overlay");
static_assert((size_t)8 * 2048 * D * 4 <= WS_SG - WS_ZONE, "merge partials overlay");
static_assert((size_t)MROWS * D * 4 <= WS_SG - WS_ZONE, "T overlay");

struct Args {
    const float* in[22];
    float* out;
    unsigned char* ws;
    int ph_lo, ph_hi;
    int coop, pad;
};

typedef __bf16 bf16v2_t __attribute__((ext_vector_type(2)));
typedef float f32x2_t __attribute__((ext_vector_type(2)));
__device__ __forceinline__ unsigned pk2(float lo, float hi) { const f32x2_t v = {lo, hi}; const bf16v2_t b = __builtin_convertvector(v, bf16v2_t); return __builtin_bit_cast(unsigned, b); }
__device__ __forceinline__ bf16_t f2bf(float f) { return (bf16_t)(pk2(f, 0.f) & 0xffffu); }
__device__ __forceinline__ float bf2f(bf16_t h) { return __uint_as_float(((unsigned)h) << 16); }
__device__ __forceinline__ float bflo(unsigned u) { return __uint_as_float(u << 16); }
__device__ __forceinline__ float bfhi(unsigned u) { return __uint_as_float(u & 0xffff0000u); }
__device__ __forceinline__ float frcp(float x) { return __builtin_amdgcn_rcpf(x); }
__device__ __forceinline__ float sigmoidf_(float x) { return frcp(1.f + __expf(-x)); }
__device__ __forceinline__ float siluf_(float x) { return x * sigmoidf_(x); }
__device__ __forceinline__ float gelu_tanh_(float x) { const float y = 0.7978845608028654f * (x + 0.044715f * x * x * x); return x * sigmoidf_(2.f * y); }
__device__ __forceinline__ float softplusf_(float x) { return fmaxf(x, 0.f) + log1pf(expf(-fabsf(x))); }
__device__ __forceinline__ float wave_sum(float v) {
#pragma unroll
    for (int o = 1; o < 64; o <<= 1) v += __shfl_xor(v, o);
    return v;
}
__device__ __forceinline__ float sum16(float v) {
#pragma unroll
    for (int o = 1; o < 16; o <<= 1) v += __shfl_xor(v, o);
    return v;
}
__device__ __forceinline__ bf16x8 scale8(bf16x8 f, const float (&s)[8]) {
    u32x4 v = __builtin_bit_cast(u32x4, f);
#pragma unroll
    for (int i = 0; i < 4; ++i) v[i] = pk2(bflo(v[i]) * s[2 * i], bfhi(v[i]) * s[2 * i + 1]);
    return __builtin_bit_cast(bf16x8, v);
}
__device__ __forceinline__ bf16x8 scale1(bf16x8 f, float s) {
    u32x4 v = __builtin_bit_cast(u32x4, f);
#pragma unroll
    for (int i = 0; i < 4; ++i) v[i] = pk2(bflo(v[i]) * s, bfhi(v[i]) * s);
    return __builtin_bit_cast(bf16x8, v);
}

namespace pg8 {
constexpr int BM = 256, BK = 64, HALF = 128, HTB = HALF * BK * 2, NXCD = 8, WGM = 8;
__device__ __forceinline__ int lds_byte(int r, int c) { const int st = (r >> 4) * 2 + (c >> 5), rr = r & 15, cc = c & 31, ob = rr * 64 + cc * 2; return st * 1024 + (ob ^ (((ob >> 9) & 1) << 5)); }
__device__ __forceinline__ void stage_rc(int b, int& R, int& C) { const int st = b / 1024, sb = b % 1024, swz = sb ^ (((sb >> 9) & 1) << 5); R = (st >> 1) * 16 + swz / 64; C = (st & 1) * 32 + (swz % 64) / 2; }

struct Unit { int pm, pn, sub, kt0, nt, sp; };
struct Gemm { const bf16_t* A0; const bf16_t* A1; const bf16_t* B0; const bf16_t* B1; int K; };

struct Sched {
    int nM, nN, G, c, flags, ntK;
    __device__ __forceinline__ void init(int nM_, int nN_, int G_, int c_, int dual_, int latonly_, int tail_, int K_) { nM = tail_ ? 64 : nM_; nN = nN_; G = G_; c = c_; flags = (dual_ ? 1 : 0) | (latonly_ ? 2 : 0) | (tail_ == 1 ? 4 : 0) | (tail_ == 2 ? 8 : 0); ntK = K_ / BK; }
    __device__ __forceinline__ void entry(int i, int& valid, int& pm, int& pn, int& sub, int& kt0, int& nt, int& sp) const {
        const int tidx = (flags & 4) ? 1 : ((flags & 8) ? 2 : 1000);
        const bool tl = i >= tidx;
        const bool tm = (flags & 8) != 0;
        const int tt = c >> 3, spv = c & 7, tpt = ntK >> 1, base = tpt >> 3, rem = tpt & 7;
        const int t_pm = 64 + (tt >> 2), t_pn = tt & 3;
        const int t_kt0 = tm ? 4 * (spv & 3) : 2 * (spv * base + (spv < rem ? spv : rem)), t_nt = tm ? 4 : 2 * (base + (spv < rem ? 1 : 0));
        const int t_sub = tm ? (2 | (spv >> 2)) : 2;
        const int nwg = nM * nN;
        const int ii = (flags & 1) ? (i >> 1) : i;
        const long L = (long)ii * G + c;
        const bool nv = L < nwg;
        int wgid = nv ? (int)L : 0; { const int q = nwg / NXCD, r = nwg % NXCD, xcd = wgid % NXCD, off = wgid / NXCD; wgid = (xcd < r ? xcd * (q + 1) : r * (q + 1) + (xcd - r) * q) + off; }
        const int nig = WGM * nN, gid = wgid / nig, fm = gid * WGM, gsz = (nM - fm) < WGM ? (nM - fm) : WGM;
        int n_pm = fm + ((wgid % nig) % gsz); const int n_pn = (wgid % nig) / gsz;
        if (flags & 2) n_pm = 9 * (n_pm >> 3) + 1 + (n_pm & 7);
        valid = tl ? (i == tidx ? 1 : 0) : (nv ? 1 : 0);
        pm = tl ? t_pm : n_pm; pn = tl ? t_pn : n_pn; sub = tl ? t_sub : ((flags & 1) ? (i & 1) : 0);
        kt0 = tl ? t_kt0 : 0; nt = tl ? t_nt : ntK; sp = tl ? spv : 0;
    }
};

__device__ __forceinline__ bool get_unit(LAS unsigned char* lds, int i, Unit& u) {
    if (i >= 16) return false;
    const LAS int* e = (const LAS int*)(lds + 131072 + 64) + 8 * i;
    const int valid = __builtin_amdgcn_readfirstlane(e[0]);
    u.pm = __builtin_amdgcn_readfirstlane(e[1]); u.pn = __builtin_amdgcn_readfirstlane(e[2]); u.sub = __builtin_amdgcn_readfirstlane(e[3]);
    u.kt0 = __builtin_amdgcn_readfirstlane(e[4]); u.nt = __builtin_amdgcn_readfirstlane(e[5]); u.sp = __builtin_amdgcn_readfirstlane(e[6]);
    return valid != 0;
}
__device__ __forceinline__ void build_units(LAS unsigned char* lds, const Sched& S) {
    const int t = threadIdx.x;
    if (t < 16) {
        int valid, pm, pn, sub, kt0, nt, sp;
        S.entry(t, valid, pm, pn, sub, kt0, nt, sp);
        asm volatile("" : "+v"(kt0), "+v"(nt), "+v"(sp), "+v"(valid));
        LAS int* e = (LAS int*)(lds + 131072 + 64) + 8 * t;
        e[0] = valid; e[1] = pm; e[2] = pn; e[3] = sub; e[4] = kt0; e[5] = nt; e[6] = sp; e[7] = 0;
    }
    __syncthreads();
}

template <class Epi>
__device__ __forceinline__ void gemm_phase(LAS unsigned char* lds, const Gemm g, const Epi& E) {
    int tid = threadIdx.x; asm volatile("" : "+v"(tid));
    const int wid = __builtin_amdgcn_readfirstlane(tid >> 6), lane = tid & 63, wr = wid >> 2, wc = wid & 3, fr = lane & 15, fq = lane >> 4;
    const int K = g.K;
    unsigned voffA[2];
#pragma unroll
    for (int i = 0; i < 2; ++i) { int R, C; stage_rc(tid * 16 + i * 8192, R, C); voffA[i] = (unsigned)(R * K + C) * 2u; }
    const size_t kstep = (size_t)(BK * 2);
    const size_t hstep = (size_t)HALF * K * 2;
    const size_t tstep = 2 * hstep;
    const unsigned ldsw = (unsigned)wid * 1024u;
    const int aoff = lds_byte(wr * 64 + fr, fq * 8), boff = lds_byte(wc * 32 + fr, fq * 8);
#define PG8_SA(b, h) (((b) * 2 + (h)) * HTB)
#define PG8_SB(b, h) ((4 + (b) * 2 + (h)) * HTB)
#define PG8_STAGE(bufoff, gbase, voff) do { _Pragma("unroll") for (int _i = 0; _i < 2; ++_i) \
        __builtin_amdgcn_global_load_lds((const unsigned*)((const char*)(gbase) + (voff)[_i]), (LAS unsigned*)(lds + (bufoff) + ldsw + _i * 8192), 16, 0, 0); } while (0)
#define PG8_LDA(dst, b, h) do { _Pragma("unroll") for (int m = 0; m < 4; ++m) _Pragma("unroll") for (int k = 0; k < 2; ++k) dst[m][k] = *(const LAS bf16x8*)(lds + PG8_SA(b, h) + aoff + m * 2048 + k * 1024); } while (0)
#define PG8_LDB(dst, b, h) do { _Pragma("unroll") for (int n = 0; n < 2; ++n) _Pragma("unroll") for (int k = 0; k < 2; ++k) dst[n][k] = *(const LAS bf16x8*)(lds + PG8_SB(b, h) + boff + n * 2048 + k * 1024); } while (0)
#define PG8_MMA(ai, bj, At, Bt) do { __builtin_amdgcn_s_setprio(1); _Pragma("unroll") for (int m = 0; m < 4; ++m) _Pragma("unroll") for (int n = 0; n < 2; ++n) _Pragma("unroll") for (int k = 0; k < 2; ++k) \
        acc[ai][bj][m][n] = __builtin_amdgcn_mfma_f32_16x16x32_bf16(Bt[n][k], At[m][k], acc[ai][bj][m][n], 0, 0, 0); __builtin_amdgcn_s_setprio(0); } while (0)
#define PG8_WAIT_V(n) asm volatile("s_waitcnt vmcnt(" #n ")" ::: "memory")
#define PG8_WAIT_L(n) asm volatile("s_waitcnt lgkmcnt(" #n ")" ::: "memory")
#define PG8_BAR __builtin_amdgcn_s_barrier()
#define PG8_SCHED __builtin_amdgcn_sched_barrier(0)
    Unit cur; int ui = 0;
    if (!get_unit(lds, 0, cur)) return;
    f32x4 acc[2][2][4][2];
#pragma unroll
    for (int a = 0; a < 2; ++a)
#pragma unroll
        for (int b = 0; b < 2; ++b)
#pragma unroll
            for (int m = 0; m < 4; ++m)
#pragma unroll
                for (int n = 0; n < 2; ++n) acc[a][b][m][n] = (f32x4){0.f, 0.f, 0.f, 0.f};
    bf16x8 At[4][2], B0[2][2], B1[2][2];
    const char* cA = (const char*)((cur.sub & 1) ? g.A1 : g.A0) + (size_t)cur.pm * tstep + (size_t)cur.kt0 * kstep; const char* cB = (const char*)((cur.sub & 1) ? g.B1 : g.B0) + (size_t)cur.pn * tstep + (size_t)cur.kt0 * kstep;
    PG8_STAGE(PG8_SB(0, 0), cB, voffA); PG8_STAGE(PG8_SB(0, 1), cB + hstep, voffA); PG8_STAGE(PG8_SA(0, 0), cA, voffA); PG8_STAGE(PG8_SA(0, 1), cA + hstep, voffA);
    if (wr == 1) PG8_BAR;
    PG8_WAIT_V(2); PG8_BAR;
    PG8_STAGE(PG8_SB(1, 0), cB + kstep, voffA); PG8_STAGE(PG8_SA(1, 0), cA + kstep, voffA); PG8_STAGE(PG8_SB(1, 1), cB + hstep + kstep, voffA);
    PG8_WAIT_V(6); PG8_BAR;
    for (;;) {
        Unit nxt; const bool has_next = get_unit(lds, ui + 1, nxt);
        const char* nA = has_next ? (const char*)((nxt.sub & 1) ? g.A1 : g.A0) + (size_t)nxt.pm * tstep + (size_t)nxt.kt0 * kstep : cA; const char* nB = has_next ? (const char*)((nxt.sub & 1) ? g.B1 : g.B0) + (size_t)nxt.pn * tstep + (size_t)nxt.kt0 * kstep : cB;
        const int nt = cur.nt;
        for (int t = 0; t < nt; t += 2) {
            const bool last = (t == nt - 2);
            const char* a1 = cA + (size_t)(t + 1) * kstep;
            const char* a2 = last ? nA : cA + (size_t)(t + 2) * kstep; const char* b2 = last ? nB : cB + (size_t)(t + 2) * kstep;
            const char* a3 = a2 + kstep; const char* b3 = b2 + kstep;
            PG8_LDB(B0, 0, 0); PG8_LDB(B1, 0, 1); PG8_SCHED; PG8_LDA(At, 0, 0); PG8_STAGE(PG8_SA(1, 1), a1 + hstep, voffA);
            PG8_WAIT_V(8); PG8_WAIT_L(0); PG8_BAR; PG8_MMA(0, 0, At, B0); PG8_MMA(0, 1, At, B1); PG8_BAR; PG8_SCHED;
            PG8_LDA(At, 0, 1); PG8_STAGE(PG8_SB(0, 0), b2, voffA); PG8_STAGE(PG8_SB(0, 1), b2 + hstep, voffA); PG8_STAGE(PG8_SA(0, 0), a2, voffA);
            PG8_WAIT_V(8); PG8_WAIT_L(0); PG8_BAR; PG8_MMA(1, 0, At, B0); PG8_MMA(1, 1, At, B1); PG8_BAR; PG8_SCHED;
            PG8_LDB(B0, 1, 0); PG8_LDB(B1, 1, 1); PG8_SCHED; PG8_LDA(At, 1, 0); PG8_STAGE(PG8_SA(0, 1), a2 + hstep, voffA);
            PG8_WAIT_V(8); PG8_WAIT_L(0); PG8_BAR; PG8_MMA(0, 0, At, B0); PG8_MMA(0, 1, At, B1); PG8_BAR; PG8_SCHED;
            PG8_LDA(At, 1, 1); PG8_STAGE(PG8_SB(1, 0), b3, voffA); PG8_STAGE(PG8_SB(1, 1), b3 + hstep, voffA); PG8_STAGE(PG8_SA(1, 0), a3, voffA);
            PG8_WAIT_V(8); PG8_WAIT_L(0); PG8_BAR; PG8_MMA(1, 0, At, B0); PG8_MMA(1, 1, At, B1); PG8_BAR; PG8_SCHED;
        }
        if (wr == 0) PG8_BAR;
        E(acc, cur, wr, wc, fr, fq);
        if (!has_next) break;
        if (!(Epi::KEEP && cur.sub == 0))
#pragma unroll
        for (int a = 0; a < 2; ++a)
#pragma unroll
            for (int b = 0; b < 2; ++b)
#pragma unroll
                for (int m = 0; m < 4; ++m)
#pragma unroll
                    for (int n = 0; n < 2; ++n) acc[a][b][m][n] = (f32x4){0.f, 0.f, 0.f, 0.f};
        ++ui; get_unit(lds, ui, cur); cA = nA; cB = nB;
        if (wr == 1) PG8_BAR;
    }
    PG8_WAIT_V(0);
    PG8_BAR;
#undef PG8_SA
#undef PG8_SB
#undef PG8_STAGE
#undef PG8_LDA
#undef PG8_LDB
#undef PG8_MMA
#undef PG8_WAIT_V
#undef PG8_WAIT_L
#undef PG8_BAR
#undef PG8_SCHED
}
}

typedef f32x4 AccT[2][2][4][2];

struct EpiRes {
    static constexpr bool KEEP = false;
    unsigned char* ws; int l; int gidx; float fac;
    __device__ __forceinline__ void operator()(const AccT& acc, const pg8::Unit& u, int wr, int wc, int fr_, int fq_) const {
        int fr = fr_, fq = fq_; asm volatile("" : "+v"(fr), "+v"(fq));
        const int b = u.pm / 9, pt = u.pm - 9 * b, mr = pt == 0 ? 8 : b;
        const int row0 = u.pm * 256 + wr * 64 + fr, col0 = u.pn * 256 + wc * 32 + 8 * fq;
        const float* mp = (const float*)(ws + WS_MODS) + ((size_t)(l * 9 + mr) * NMOD + (size_t)gidx * D);
        bf16_t* R = (bf16_t*)(ws + WS_R);
        f32x4 gv[2][2];
#pragma unroll
        for (int bj = 0; bj < 2; ++bj)
#pragma unroll
            for (int n = 0; n < 2; ++n) gv[bj][n] = *(const f32x4*)(mp + col0 + bj * 128 + n * 4) * fac;
        if (u.sub & 2) {
            bf16_t* P = (bf16_t*)(ws + WS_PART) + (size_t)u.sp * (2048 * D);
#pragma unroll
            for (int ai = 0; ai < 2; ++ai)
#pragma unroll
                for (int m = 0; m < 4; ++m) {
                    bf16_t* rowp = P + (size_t)(row0 - 16384 + ai * 128 + m * 16) * D + col0;
#pragma unroll
                    for (int bj = 0; bj < 2; ++bj) {
                        const f32x4 t0 = gv[bj][0] * acc[ai][bj][m][0], t1 = gv[bj][1] * acc[ai][bj][m][1];
                        u32x4 o; o[0] = pk2(t0[0], t0[1]); o[1] = pk2(t0[2], t0[3]); o[2] = pk2(t1[0], t1[1]); o[3] = pk2(t1[2], t1[3]);
                        *(u32x4*)(rowp + bj * 128) = o;
                    }
                }
            return;
        }
#pragma unroll
        for (int ai = 0; ai < 2; ++ai)
#pragma unroll
            for (int m = 0; m < 4; ++m) {
                bf16_t* rowp = R + (size_t)(row0 + ai * 128 + m * 16) * D + col0;
#pragma unroll
                for (int bj = 0; bj < 2; ++bj) {
                    const u32x4 rv = *(const u32x4*)(rowp + bj * 128);
                    f32x4 r0, r1; r0[0] = bflo(rv[0]); r0[1] = bfhi(rv[0]); r0[2] = bflo(rv[1]); r0[3] = bfhi(rv[1]); r1[0] = bflo(rv[2]); r1[1] = bfhi(rv[2]); r1[2] = bflo(rv[3]); r1[3] = bfhi(rv[3]);
                    r0 += gv[bj][0] * acc[ai][bj][m][0]; r1 += gv[bj][1] * acc[ai][bj][m][1];
                    u32x4 o; o[0] = pk2(r0[0], r0[1]); o[1] = pk2(r0[2], r0[3]); o[2] = pk2(r1[0], r1[1]); o[3] = pk2(r1[2], r1[3]);
                    *(u32x4*)(rowp + bj * 128) = o;
                }
            }
    }
};

struct EpiSwiglu {
    static constexpr bool KEEP = false;
    unsigned char* ws;
    __device__ __forceinline__ void operator()(const AccT& acc, const pg8::Unit& u, int wr, int wc, int fr_, int fq_) const {
        int fr = fr_, fq = fq_; asm volatile("" : "+v"(fr), "+v"(fq));
        const int row0 = u.pm * 256 + wr * 64 + fr;
        bf16_t* H = (bf16_t*)(ws + WS_H) + 128 * u.pn + 32 * wc + 8 * fq;
#pragma unroll
        for (int ai = 0; ai < 2; ++ai)
#pragma unroll
            for (int m = 0; m < 4; ++m) {
                const f32x4 u0 = acc[ai][0][m][0], u1 = acc[ai][0][m][1], v0 = acc[ai][1][m][0], v1 = acc[ai][1][m][1];
                u32x4 o;
                o[0] = pk2(siluf_(u0[0]) * v0[0], siluf_(u0[1]) * v0[1]); o[1] = pk2(siluf_(u0[2]) * v0[2], siluf_(u0[3]) * v0[3]);
                o[2] = pk2(siluf_(u1[0]) * v1[0], siluf_(u1[1]) * v1[1]); o[3] = pk2(siluf_(u1[2]) * v1[2], siluf_(u1[3]) * v1[3]);
                *(u32x4*)(H + (size_t)(row0 + ai * 128 + m * 16) * FH) = o;
            }
    }
};

struct EpiWin {
    static constexpr bool KEEP = false;
    unsigned char* ws;
    __device__ __forceinline__ void operator()(const AccT& acc, const pg8::Unit& u, int wr, int wc, int fr_, int fq_) const {
        int fr = fr_, fq = fq_; asm volatile("" : "+v"(fr), "+v"(fq));
        const int b = u.pm / 9, pt = u.pm - 9 * b;
        const int pn = u.pn;
        const float* rope = (const float*)(ws + WS_ROPE);
        bf16_t* const Q = (bf16_t*)(ws + WS_Q); bf16_t* const KN = (bf16_t*)(ws + WS_KN); bf16_t* const KT = (bf16_t*)(ws + WS_KT); bf16_t* const VT = (bf16_t*)(ws + WS_VT);
        const int rl0 = wr * 64 + fr;
        if (pn < 4) {
            const bool isk = pn >= 2;
            const int jj0 = 16 * (wc & 1) + 4 * fq;
#pragma unroll
            for (int ai = 0; ai < 2; ++ai)
#pragma unroll
                for (int m = 0; m < 4; ++m) {
                    const int rl = rl0 + ai * 128 + m * 16;
                    const size_t row = (size_t)u.pm * 256 + rl;
                    f32x4 cs = (f32x4){1.f, 1.f, 1.f, 1.f}, sn = (f32x4){0.f, 0.f, 0.f, 0.f};
                    if (pt != 0) { const int tpos = (pt - 1) * 256 + rl; cs = *(const f32x4*)(rope + (size_t)tpos * 32 + jj0); sn = *(const f32x4*)(rope + (size_t)SEQ * 32 + (size_t)tpos * 32 + jj0); }
#pragma unroll
                    for (int bj = 0; bj < 2; ++bj) {
                        const int hq = 4 * (pn & 1) + 2 * bj + (wc >> 1);
                        const f32x4 a1 = acc[ai][bj][m][0], a2 = acc[ai][bj][m][1];
                        f32x4 o1 = a1 * cs - a2 * sn, o2 = a1 * sn + a2 * cs;
                        if (isk) { o1 *= 0.125f; o2 *= 0.125f; }
                        u32x2 p1, p2; p1.x = pk2(o1[0], o1[1]); p1.y = pk2(o1[2], o1[3]); p2.x = pk2(o2[0], o2[1]); p2.y = pk2(o2[2], o2[3]);
                        bf16_t* dst = (isk ? KN : Q) + row * 512 + hq * 64 + jj0;
                        *(u32x2*)dst = p1; *(u32x2*)(dst + 32) = p2;
                        if (isk) {
                            bf16_t* kt = KT + ((size_t)(b * NH + hq) * DK + jj0) * TB + pt * 256 + rl;
                            kt[0] = (bf16_t)(p1.x & 0xffffu); kt[(size_t)TB] = (bf16_t)(p1.x >> 16); kt[(size_t)2 * TB] = (bf16_t)(p1.y & 0xffffu); kt[(size_t)3 * TB] = (bf16_t)(p1.y >> 16);
                            bf16_t* kt2 = kt + (size_t)32 * TB;
                            kt2[0] = (bf16_t)(p2.x & 0xffffu); kt2[(size_t)TB] = (bf16_t)(p2.x >> 16); kt2[(size_t)2 * TB] = (bf16_t)(p2.y & 0xffffu); kt2[(size_t)3 * TB] = (bf16_t)(p2.y >> 16);
                        }
                    }
                    __builtin_amdgcn_sched_barrier(0);
                }
        } else if (pn < 8) {
#pragma unroll
            for (int ai = 0; ai < 2; ++ai)
#pragma unroll
                for (int m = 0; m < 4; ++m) {
                    const int rl = rl0 + ai * 128 + m * 16;
#pragma unroll
                    for (int bj = 0; bj < 2; ++bj) {
                        const int hv = 2 * (pn - 4) + bj;
#pragma unroll
                        for (int n = 0; n < 2; ++n) {
                            const int dv = 32 * wc + 16 * n + 4 * fq;
                            bf16_t* vt = VT + ((size_t)(b * NH + hv) * DV + dv) * TB + pt * 256 + rl;
                            const f32x4 a = acc[ai][bj][m][n];
                            const unsigned p0 = pk2(a[0], a[1]), p1 = pk2(a[2], a[3]);
                            vt[0] = (bf16_t)(p0 & 0xffffu); vt[(size_t)TB] = (bf16_t)(p0 >> 16); vt[(size_t)2 * TB] = (bf16_t)(p1 & 0xffffu); vt[(size_t)3 * TB] = (bf16_t)(p1 >> 16);
                        }
                        __builtin_amdgcn_sched_barrier(0);
                    }
                }
        } else {
            const int seg = (pn - 8) >> 2;
            bf16_t* base = (bf16_t*)(ws + WS_SG + (size_t)seg * ((size_t)MROWS * D * 2));
            const int cbase = 256 * ((pn - 8) & 3) + wc * 32 + 8 * fq;
#pragma unroll
            for (int ai = 0; ai < 2; ++ai)
#pragma unroll
                for (int m = 0; m < 4; ++m) {
                    const size_t row = (size_t)u.pm * 256 + rl0 + ai * 128 + m * 16;
#pragma unroll
                    for (int bj = 0; bj < 2; ++bj) {
                        f32x4 a0 = acc[ai][bj][m][0], a1 = acc[ai][bj][m][1];
                        if (seg == 0) { a0[0] = siluf_(a0[0]); a0[1] = siluf_(a0[1]); a0[2] = siluf_(a0[2]); a0[3] = siluf_(a0[3]); a1[0] = siluf_(a1[0]); a1[1] = siluf_(a1[1]); a1[2] = siluf_(a1[2]); a1[3] = siluf_(a1[3]); }
                        else if (seg == 2) { a0[0] = gelu_tanh_(a0[0]); a0[1] = gelu_tanh_(a0[1]); a0[2] = gelu_tanh_(a0[2]); a0[3] = gelu_tanh_(a0[3]); a1[0] = gelu_tanh_(a1[0]); a1[1] = gelu_tanh_(a1[1]); a1[2] = gelu_tanh_(a1[2]); a1[3] = gelu_tanh_(a1[3]); }
                        else if (seg >= 3) { a0[0] = sigmoidf_(a0[0]); a0[1] = sigmoidf_(a0[1]); a0[2] = sigmoidf_(a0[2]); a0[3] = sigmoidf_(a0[3]); a1[0] = sigmoidf_(a1[0]); a1[1] = sigmoidf_(a1[1]); a1[2] = sigmoidf_(a1[2]); a1[3] = sigmoidf_(a1[3]); }
                        u32x4 o; o[0] = pk2(a0[0], a0[1]); o[1] = pk2(a0[2], a0[3]); o[2] = pk2(a1[0], a1[1]); o[3] = pk2(a1[2], a1[3]);
                        *(u32x4*)(base + row * D + cbase + bj * 128) = o;
                    }
                }
        }
    }
};

struct EpiMerge {
    static constexpr bool KEEP = true;
    unsigned char* ws;
    __device__ __forceinline__ void operator()(AccT& acc, const pg8::Unit& u, int wr, int wc, int fr_, int fq_) const {
        int fr = fr_, fq = fq_; asm volatile("" : "+v"(fr), "+v"(fq));
        const int row0 = u.pm * 256 + wr * 64 + fr, col0 = u.pn * 256 + wc * 32 + 8 * fq;
        const bf16_t* GA = (const bf16_t*)(ws + WS_GA); const bf16_t* GB = (const bf16_t*)(ws + WS_GB);
        bf16_t* MB = (bf16_t*)(ws + WS_SG);
        if (u.sub & 2) {
            const bf16_t* G = (u.sub & 1) ? GB : GA;
            bf16_t* P = (bf16_t*)(ws + WS_PART2) + (size_t)u.sp * (2048 * D);
#pragma unroll
            for (int ai = 0; ai < 2; ++ai)
#pragma unroll
                for (int m = 0; m < 4; ++m) {
                    const size_t ro = (size_t)(row0 + ai * 128 + m * 16) * D + col0;
                    const size_t po = (size_t)(row0 - 16384 + ai * 128 + m * 16) * D + col0;
#pragma unroll
                    for (int bj = 0; bj < 2; ++bj) {
                        const u32x4 gv = *(const u32x4*)(G + ro + bj * 128);
                        f32x4 s0, s1; s0[0] = bflo(gv[0]); s0[1] = bfhi(gv[0]); s0[2] = bflo(gv[1]); s0[3] = bfhi(gv[1]); s1[0] = bflo(gv[2]); s1[1] = bfhi(gv[2]); s1[2] = bflo(gv[3]); s1[3] = bfhi(gv[3]);
                        const f32x4 t0 = s0 * acc[ai][bj][m][0], t1 = s1 * acc[ai][bj][m][1];
                        u32x4 o; o[0] = pk2(t0[0], t0[1]); o[1] = pk2(t0[2], t0[3]); o[2] = pk2(t1[0], t1[1]); o[3] = pk2(t1[2], t1[3]);
                        *(u32x4*)(P + po + bj * 128) = o;
                    }
                }
            return;
        }
#pragma unroll
        for (int ai = 0; ai < 2; ++ai)
#pragma unroll
            for (int m = 0; m < 4; ++m) {
                const size_t ro = (size_t)(row0 + ai * 128 + m * 16) * D + col0;
#pragma unroll
                for (int bj = 0; bj < 2; ++bj) {
                    const size_t o = ro + bj * 128;
                    const u32x4 gb = *(const u32x4*)(GB + o);
                    f32x4 b0, b1;
                    b0[0] = fmaxf(bflo(gb[0]), 1e-6f); b0[1] = fmaxf(bfhi(gb[0]), 1e-6f); b0[2] = fmaxf(bflo(gb[1]), 1e-6f); b0[3] = fmaxf(bfhi(gb[1]), 1e-6f);
                    b1[0] = fmaxf(bflo(gb[2]), 1e-6f); b1[1] = fmaxf(bfhi(gb[2]), 1e-6f); b1[2] = fmaxf(bflo(gb[3]), 1e-6f); b1[3] = fmaxf(bfhi(gb[3]), 1e-6f);
                    if ((u.sub & 1) == 0) {
                        const u32x4 ga = *(const u32x4*)(GA + o);
                        f32x4 a0, a1; a0[0] = bflo(ga[0]); a0[1] = bfhi(ga[0]); a0[2] = bflo(ga[1]); a0[3] = bfhi(ga[1]); a1[0] = bflo(ga[2]); a1[1] = bfhi(ga[2]); a1[2] = bflo(ga[3]); a1[3] = bfhi(ga[3]);
#pragma unroll
                        for (int j = 0; j < 4; ++j) { acc[ai][bj][m][0][j] *= a0[j] * frcp(b0[j]); acc[ai][bj][m][1][j] *= a1[j] * frcp(b1[j]); }
                    } else {
                        const f32x4 t0 = b0 * acc[ai][bj][m][0], t1 = b1 * acc[ai][bj][m][1];
                        u32x4 w; w[0] = pk2(t0[0], t0[1]); w[1] = pk2(t0[2], t0[3]); w[2] = pk2(t1[0], t1[1]); w[3] = pk2(t1[2], t1[3]);
                        *(u32x4*)(MB + o) = w;
                    }
                }
            }
    }
};

#define XB_TMO      128
#define XB_XCNT(j)  (256  + 64 * (j))
#define XB_XSUB(j)  (1280 + 64 * (j))
#define XB_XGEN(j)  (2304 + 64 * (j))
#define XB_TOP      3328
#define XB_TOPGEN   3392
#define XCD_BAR_WORDS 3456
#define XB_SPIN_CAP (1u << 18)

__device__ __forceinline__ unsigned xb_ld(unsigned* p)              { return __hip_atomic_load(p, __ATOMIC_RELAXED, __HIP_MEMORY_SCOPE_AGENT); }
__device__ __forceinline__ unsigned xb_add(unsigned* p, unsigned v) { return __hip_atomic_fetch_add(p, v, __ATOMIC_RELAXED, __HIP_MEMORY_SCOPE_AGENT); }
__device__ __forceinline__ unsigned xb_xcc_id() { return (unsigned)__builtin_amdgcn_s_getreg((3 << 11) | 20) & 0xFu; }
#define XB_SPIN(cond, bar) do { unsigned _sp = 0; while (cond) { __builtin_amdgcn_s_sleep(1); \
    if ((++_sp & 255u) == 0u) { if (xb_ld(&(bar)[XB_TMO])) break; if (_sp > XB_SPIN_CAP) { atomicAdd(&(bar)[XB_TMO], 1u); break; } } } } while (0)

struct XcdBarrier {
    unsigned* bar; unsigned x;
    volatile LAS unsigned* st;
};

__device__ __forceinline__ XcdBarrier xcd_barrier_post(unsigned* bar, volatile LAS unsigned* st) {
    XcdBarrier b; b.bar = bar; b.x = xb_xcc_id(); b.st = st;
    if (threadIdx.x == 0) (void)xb_add(&bar[XB_XCNT(b.x)], 1u);
    return b;
}
__device__ __forceinline__ void xcd_barrier_complete(unsigned* bar, unsigned x, unsigned& nloc, unsigned& nx) {
    const unsigned G = gridDim.x * gridDim.y * gridDim.z;
    unsigned sum, cnt, mine, sp = 0u;
    for (;;) {
        sum = 0u; cnt = 0u; mine = 0u;
#pragma unroll
        for (unsigned j = 0; j < 16; ++j) { const unsigned c = xb_ld(&bar[XB_XCNT(j)]); sum += c; cnt += (c > 0u) ? 1u : 0u; mine = (j == x) ? c : mine; }
        if (sum == G) break;
        __builtin_amdgcn_s_sleep(1);
        if ((++sp & 255u) == 0u) { if (xb_ld(&bar[XB_TMO])) break; if (sp > XB_SPIN_CAP) { atomicAdd(&bar[XB_TMO], 1u); break; } }
    }
    nloc = mine > 0u ? mine : 1u; nx = cnt > 0u ? cnt : 1u;
}

__device__ __forceinline__ void xcd_barrier(const XcdBarrier& b) {
    asm volatile("s_waitcnt vmcnt(0)" ::: "memory");
    __syncthreads();
    if (threadIdx.x == 0) {
        unsigned* bar = b.bar;
        __builtin_amdgcn_s_waitcnt(0);
        unsigned nloc = b.st[0], nx = b.st[1];
        if (nloc == 0u) { xcd_barrier_complete(bar, b.x, nloc, nx); b.st[0] = nloc; b.st[1] = nx; }
        const unsigned old = xb_add(&bar[XB_XSUB(b.x)], 1u);
        const unsigned gen = old / nloc;
        if (old + 1u == (gen + 1u) * nloc) {
            __builtin_amdgcn_fence(__ATOMIC_RELEASE, "agent");
            asm volatile("s_waitcnt vmcnt(0)" ::: "memory");
            const unsigned og = xb_add(&bar[XB_TOP], 1u);
            const unsigned tg = og / nx;
            if (og + 1u == (tg + 1u) * nx) xb_add(&bar[XB_TOPGEN], 1u);
            else XB_SPIN(xb_ld(&bar[XB_TOPGEN]) == tg, bar);
            __builtin_amdgcn_fence(__ATOMIC_ACQUIRE, "agent");
            xb_add(&bar[XB_XGEN(b.x)], 1u);
            asm volatile("s_waitcnt vmcnt(0)" ::: "memory");
        } else {
            XB_SPIN(xb_ld(&bar[XB_XGEN(b.x)]) == gen, bar);
            __builtin_amdgcn_fence(__ATOMIC_ACQUIRE, "agent");
            asm volatile("s_waitcnt vmcnt(0)" ::: "memory");
        }
    }
    __syncthreads();
}


struct Frame;
struct Frame {
    LAS unsigned char* lds;
    int tid, lane, wave, G, bid, z;
    unsigned char* ws;
};
__device__ __forceinline__ void refresh(Frame& F);
#define GIN(i) ((const float*)(GAS const float*)(unsigned long long)A.in[(i) + F.z])
#define WSF(off) ((float*)(F.ws + (off)))
#define WSB(off) ((bf16_t*)(F.ws + (off)))

__device__ __forceinline__ void refresh(Frame& F) { int t = threadIdx.x; asm volatile("" : "+v"(t)); F.tid = t; F.lane = t & 63; F.wave = __builtin_amdgcn_readfirstlane(t >> 6); }
__device__ __forceinline__ int perm32(int rho) { const int n = rho >> 4, i = rho & 15; return 8 * (i >> 2) + 4 * n + (i & 3); }
__device__ __forceinline__ int srccol(int kind, int np) {
    if (kind == 1) { const int t = np >> 8, bj = (np >> 7) & 1, wc = (np >> 5) & 3; return bj * FH + 128 * t + 32 * wc + perm32(np & 31); }
    if (kind == 2 && np < 1024) { const int seg = np >> 9, r = np & 511, G = r >> 5, h = G >> 1, s = G & 1, n = (r >> 4) & 1, i = r & 15; return seg * 512 + h * 64 + 32 * n + 16 * s + i; }
    if ((kind == 2 && np >= 2048) || kind == 3) return (np & ~31) + perm32(np & 31);
    return np;
}
struct CvtMat { const float* W; bf16_t* Bt; int K, N, kind; };
__device__ __forceinline__ void cvt_pick(const Args& A, const Frame& F, int l, int it, CvtMat& m, int& tt) {
    constexpr int T_GU = 16 * 44, T_D = 44 * 8, T_IN = 16 * 56, T_SQ = 16 * 8;
    constexpr int O1 = T_GU, O2 = O1 + T_D, O3 = O2 + T_GU, O4 = O3 + T_D, O5 = O4 + T_IN, O6 = O5 + T_SQ, O7 = O6 + T_SQ;
    const int sel = (it >= O1) + (it >= O2) + (it >= O3) + (it >= O4) + (it >= O5) + (it >= O6) + (it >= O7);
    const int inidx = sel == 0 ? 7 : sel == 1 ? 8 : sel == 2 ? 9 : sel == 3 ? 10 : sel == 4 ? 11 : sel == 5 ? 13 : sel == 6 ? 19 : 20;
    const size_t per_layer = (sel == 0 || sel == 2) ? (size_t)D * 2 * FH : (sel == 1 || sel == 3) ? (size_t)FH * D : sel == 4 ? (size_t)D * PW : (size_t)D * D;
    const size_t woff = sel == 0 ? WS_WGU1 : sel == 1 ? WS_WD1 : sel == 2 ? WS_WGU2 : sel == 3 ? WS_WD2 : sel == 4 ? WS_WIN : sel == 5 ? WS_WRO : sel == 6 ? WS_WLO : WS_WOUT;
    m.W = GIN(inidx) + (size_t)l * per_layer; m.Bt = WSB(woff);
    m.K = (sel == 1 || sel == 3) ? FH : D; m.N = (sel == 0 || sel == 2) ? 2 * FH : (sel == 4 ? PW : D); m.kind = (sel == 0 || sel == 2) ? 1 : (sel == 4 ? 2 : 3);
    tt = it - (sel == 0 ? 0 : sel == 1 ? O1 : sel == 2 ? O2 : sel == 3 ? O3 : sel == 4 ? O4 : sel == 5 ? O5 : sel == 6 ? O6 : O7);
}
__device__ __forceinline__ void cvt_load(const Frame& F, const CvtMat& m, int tt, f32x4 (&v)[4]) {
    const int nb = m.N >> 7, kb = tt / nb, nbk = tt - kb * nb, k0 = kb * 64, n0 = nbk * 128;
    const int src = srccol(m.kind, n0 + (F.tid & 31) * 4);
#pragma unroll
    for (int i = 0; i < 4; ++i) v[i] = *(const f32x4*)(m.W + (size_t)(k0 + (F.tid >> 5) + 16 * i) * m.N + src);
}
__device__ __forceinline__ void cvt_store(const Frame& F, const CvtMat& m, int tt, const f32x4 (&v)[4]) {
    LAS float* tile = (LAS float*)F.lds;
    const int nb = m.N >> 7, kb = tt / nb, nbk = tt - kb * nb, k0 = kb * 64, n0 = nbk * 128;
    const int tid = F.tid;
#pragma unroll
    for (int i = 0; i < 4; ++i) {
        const int kk = (tid >> 5) + 16 * i, nn = (tid & 31) * 4;
        tile[kk * 129 + nn] = v[i][0]; tile[kk * 129 + nn + 1] = v[i][1]; tile[kk * 129 + nn + 2] = v[i][2]; tile[kk * 129 + nn + 3] = v[i][3];
    }
    __syncthreads();
    {
        const int n = tid >> 2, ks = (tid & 3) * 16;
        u32x4 o0, o1;
#pragma unroll
        for (int i = 0; i < 4; ++i) o0[i] = pk2(tile[(ks + 2 * i) * 129 + n], tile[(ks + 2 * i + 1) * 129 + n]);
#pragma unroll
        for (int i = 0; i < 4; ++i) o1[i] = pk2(tile[(ks + 8 + 2 * i) * 129 + n], tile[(ks + 8 + 2 * i + 1) * 129 + n]);
        bf16_t* dst = m.Bt + (size_t)(n0 + n) * m.K + k0 + ks;
        *(u32x4*)dst = o0; *(u32x4*)(dst + 8) = o1;
    }
    __syncthreads();
}
__device__ __forceinline__ void convert_layer(const Args& A, Frame& F, int l) {
    refresh(F);
    constexpr int NT = 2 * 16 * 44 + 2 * 44 * 8 + 16 * 56 + 3 * 16 * 8;
    const int nmy = (NT - F.bid + F.G - 1) / F.G;
    f32x4 v[4];
    { CvtMat m; int tt; cvt_pick(A, F, l, F.bid, m, tt); cvt_load(F, m, tt, v); }
    for (int j = 0; j < nmy; ++j) {
        const int it = F.bid + j * F.G, itn = (j + 1 < nmy) ? it + F.G : it;
        f32x4 vn[4];
        { CvtMat mn; int ttn; cvt_pick(A, F, l, itn, mn, ttn); cvt_load(F, mn, ttn, vn); }
        { CvtMat m; int tt; cvt_pick(A, F, l, it, m, tt); cvt_store(F, m, tt, v); }
#pragma unroll
        for (int i = 0; i < 4; ++i) v[i] = vn[i];
    }
}

__device__ __forceinline__ void mods_phase(const Args& A, Frame& F) {
    refresh(F);
    LAS float* sv = (LAS float*)F.lds;
    LAS float* red = sv + 9 * 1024;
    for (int e = F.tid; e < 9 * 1024; e += NTHREADS) { const int r = e >> 10, k = e & 1023; const float c = r < 8 ? GIN(1)[r * D + k] : GIN(3)[k]; sv[e] = siluf_(c); }
    __syncthreads();
    const int col = F.tid & 127, kq = F.tid >> 7;
    for (int it = F.bid; it < NL * 72; it += F.G) {
        const int l = it / 72, cgp = it - l * 72, n = cgp * 128 + col;
        const float* wp = GIN(4) + (size_t)l * D * NMOD + n;
        float a[9];
#pragma unroll
        for (int r = 0; r < 9; ++r) a[r] = 0.f;
        for (int k0 = kq * 256; k0 < kq * 256 + 256; k0 += 16) {
            float w[16];
#pragma unroll
            for (int j = 0; j < 16; ++j) w[j] = wp[(size_t)(k0 + j) * NMOD];
#pragma unroll
            for (int r = 0; r < 9; ++r) {
#pragma unroll
                for (int j4 = 0; j4 < 4; ++j4) {
                    const f32x4 sv4 = *(const LAS f32x4*)(sv + r * 1024 + k0 + 4 * j4);
                    a[r] += sv4[0] * w[4 * j4] + sv4[1] * w[4 * j4 + 1] + sv4[2] * w[4 * j4 + 2] + sv4[3] * w[4 * j4 + 3];
                }
            }
        }
#pragma unroll
        for (int r = 0; r < 9; ++r) red[(kq * 9 + r) * 128 + col] = a[r];
        __syncthreads();
        for (int e = F.tid; e < 9 * 128; e += NTHREADS) {
            const int r = e >> 7, c2 = e & 127, n2 = cgp * 128 + c2;
            const float s = red[(0 * 9 + r) * 128 + c2] + red[(1 * 9 + r) * 128 + c2] + red[(2 * 9 + r) * 128 + c2] + red[(3 * 9 + r) * 128 + c2];
            WSF(WS_MODS)[(size_t)(l * 9 + r) * NMOD + n2] = s + GIN(5)[(size_t)l * NMOD + n2];
        }
        __syncthreads();
    }
}
__device__ __forceinline__ void init_phase(const Args& A, Frame& F) {
    refresh(F);
    const size_t nunits = (size_t)MROWS * D / 4;
    for (size_t uidx = (size_t)F.bid * NTHREADS + F.tid; uidx < nunits; uidx += (size_t)F.G * NTHREADS) {
        const size_t row = uidx >> 8; const int c4 = (int)(uidx & 255) * 4;
        const int b = (int)(row / TB), p = (int)(row - (size_t)b * TB);
        const float* src = p < CTXL ? GIN(2) + ((size_t)b * CTXL + p) * D + c4 : GIN(0) + ((size_t)b * SEQ + (p - CTXL)) * D + c4;
        { const f32x4 xv = *(const f32x4*)src; u32x2 o; o.x = pk2(xv[0], xv[1]); o.y = pk2(xv[2], xv[3]); *(u32x2*)(WSB(WS_R) + row * D + c4) = o; }
    }
    for (int e = F.bid * NTHREADS + F.tid; e < SEQ * 32; e += F.G * NTHREADS) {
        const int t = e >> 5, j = e & 31, f = j & 15;
        const float pos = j < 16 ? (float)(t >> 6) : (float)(t & 63);
        const float inv = powf(10000.f, -(float)f / 16.f);
        float s, c; sincosf(pos * inv, &s, &c);
        WSF(WS_ROPE)[e] = c; WSF(WS_ROPE)[SEQ * 32 + e] = s;
    }
}

__device__ __forceinline__ void norm_phase(const Args& A, Frame& F, int l, int s, bool latonly, bool tailsum) {
    refresh(F);
    const float* g = GIN(6) + (size_t)(l * 3 + s) * D;
    const int stride = F.G * 8;
    int row = F.bid * 8 + F.wave;
    f32x4 gvh[4];
#pragma unroll
    for (int j = 0; j < 4; ++j) gvh[j] = *(const f32x4*)(g + 4 * (F.lane + 64 * j));
    u32x2 nx[4];
    if (row < MROWS) { const u32x2* xr0 = (const u32x2*)(WSB(WS_R) + (size_t)row * D) + F.lane;
#pragma unroll
        for (int j = 0; j < 4; ++j) nx[j] = xr0[64 * j]; }
    for (; row < MROWS; row += stride) {
        u32x2 cx[4];
#pragma unroll
        for (int j = 0; j < 4; ++j) cx[j] = nx[j];
        { const int rn = row + stride < MROWS ? row + stride : row;
          const u32x2* xrn = (const u32x2*)(WSB(WS_R) + (size_t)rn * D) + F.lane;
#pragma unroll
          for (int j = 0; j < 4; ++j) nx[j] = xrn[64 * j]; }
        const int b = row / TB, p = row - b * TB, mr = p < CTXL ? 8 : b;
        if (latonly && p < CTXL) continue;
        f32x4 v[4]; float ss = 0.f;
#pragma unroll
        for (int j = 0; j < 4; ++j) { const u32x2 xv = cx[j]; v[j][0] = bflo(xv.x); v[j][1] = bfhi(xv.x); v[j][2] = bflo(xv.y); v[j][3] = bfhi(xv.y); }
        if (tailsum && row >= 16384) {
#pragma unroll
            for (int sp = 0; sp < 8; ++sp) {
                const u32x2* pr = (const u32x2*)(WSB(WS_PART) + ((size_t)sp * 2048 + (row - 16384)) * D) + F.lane;
#pragma unroll
                for (int j = 0; j < 4; ++j) { const u32x2 pv = pr[64 * j]; v[j][0] += bflo(pv.x); v[j][1] += bfhi(pv.x); v[j][2] += bflo(pv.y); v[j][3] += bfhi(pv.y); }
            }
            u32x2* xw = (u32x2*)(WSB(WS_R) + (size_t)row * D) + F.lane;
#pragma unroll
            for (int j = 0; j < 4; ++j) { u32x2 o; o.x = pk2(v[j][0], v[j][1]); o.y = pk2(v[j][2], v[j][3]); xw[64 * j] = o; v[j][0] = bflo(o.x); v[j][1] = bfhi(o.x); v[j][2] = bflo(o.y); v[j][3] = bfhi(o.y); }
        }
#pragma unroll
        for (int j = 0; j < 4; ++j) ss += (v[j][0] * v[j][0] + v[j][1] * v[j][1]) + (v[j][2] * v[j][2] + v[j][3] * v[j][3]);
        const float rstd = rsqrtf(wave_sum(ss) * (1.f / D) + EPS);
        const float* mp = WSF(WS_MODS) + (size_t)(l * 9 + mr) * NMOD + (size_t)(3 * s) * D;
        u32x2* o8 = (u32x2*)(WSB(WS_AN) + (size_t)row * D) + F.lane;
#pragma unroll
        for (int j = 0; j < 4; ++j) {
            const int col = 4 * (F.lane + 64 * j);
            const f32x4 gv = gvh[j], sh = *(const f32x4*)(mp + col), sc = *(const f32x4*)(mp + D + col);
            const f32x4 y = (v[j] * rstd * gv) * (sc + 1.f) + sh;
            u32x2 o; o.x = pk2(y[0], y[1]); o.y = pk2(y[2], y[3]);
            o8[64 * j] = o;
        }
    }
}
__device__ __forceinline__ void final_phase(const Args& A, Frame& F) {
    refresh(F);
    const float* g = GIN(21);
    for (int r = F.bid * 8 + F.wave; r < NB * SEQ; r += F.G * 8) {
        const int b = r >> 11, t = r & 2047;
        const u32x2* xr = (const u32x2*)(WSB(WS_R) + ((size_t)b * TB + CTXL + t) * D) + F.lane;
        f32x4 v[4]; float ss = 0.f;
#pragma unroll
        for (int j = 0; j < 4; ++j) { const u32x2 xv = xr[64 * j]; v[j][0] = bflo(xv.x); v[j][1] = bfhi(xv.x); v[j][2] = bflo(xv.y); v[j][3] = bfhi(xv.y); ss += (v[j][0] * v[j][0] + v[j][1] * v[j][1]) + (v[j][2] * v[j][2] + v[j][3] * v[j][3]); }
        const float rstd = rsqrtf(wave_sum(ss) * (1.f / D) + EPS);
        f32x4* o = (f32x4*)((float*)(GAS float*)(unsigned long long)A.out + (size_t)r * D) + F.lane;
#pragma unroll
        for (int j = 0; j < 4; ++j) { const f32x4 gv = *(const f32x4*)(g + 4 * (F.lane + 64 * j)); o[64 * j] = v[j] * rstd * gv; }
    }
}

__device__ __forceinline__ float log2_gamma(const Args& A, const Frame& F, int l, int dir, int h) {
    const float x = GIN(12)[(l * 2 + dir) * NH + h];
    return -softplusf_(-x) * 1.4426950408889634f;
}

__device__ __forceinline__ void ret_state_item(const Args& A, Frame& F, int l, int it) {
    refresh(F);
    const int dvh = it & 1, dir = (it >> 1) & 1, h = (it >> 2) & 7, b = it >> 5;
    const int lane = F.lane, fr = lane & 15, fq = lane >> 4, w = F.wave, dvt = w & 3, dkh = w >> 2;
    const float l2g = log2_gamma(A, F, l, dir, h);
    const float cdec = exp2f(128.f * l2g);
    float dec[4][8];
#pragma unroll
    for (int ks = 0; ks < 4; ++ks)
#pragma unroll
        for (int s = 0; s < 8; ++s) { const int a = 32 * ks + 8 * fq + s; dec[ks][s] = exp2f(l2g * (float)(dir ? a : 127 - a)); }
    const int dvrow = 64 * dvh + 16 * dvt + fr;
    const bf16_t* kbase = WSB(WS_KT) + ((size_t)(b * NH + h) * DK + 32 * dkh + fr) * TB;
    const bf16_t* vbase = WSB(WS_VT) + ((size_t)(b * NH + h) * DV + dvrow) * TB;
    f32x4 acc[2];
    acc[0] = (f32x4){0.f, 0.f, 0.f, 0.f}; acc[1] = acc[0];
    bf16x8 ka[4][2], va[4], kb2[4][2], vb2[4];
#define ST_MC(step_) (dir == 0 ? (step_) : ((step_) < 2 ? 1 - (step_) : 19 - (step_)))
#define ST_LOAD(KS, VS, mc_) do { const int _p0 = 128 * (mc_); _Pragma("unroll") for (int ks = 0; ks < 4; ++ks) { VS[ks] = *(const bf16x8*)(vbase + _p0 + 32 * ks + 8 * fq); \
        _Pragma("unroll") for (int t = 0; t < 2; ++t) KS[ks][t] = *(const bf16x8*)(kbase + (size_t)(16 * t) * TB + _p0 + 32 * ks + 8 * fq); } } while (0)
#define ST_STORE(mc_) do { bf16_t* stp = WSB(WS_ST) + ((((size_t)(b * NH + h) * 2 + dir) * NCH + (mc_)) * DV + dvrow) * DK + 32 * dkh + 4 * fq; \
        _Pragma("unroll") for (int t = 0; t < 2; ++t) { u32x2 o; o.x = pk2(acc[t][0], acc[t][1]); o.y = pk2(acc[t][2], acc[t][3]); *(u32x2*)(stp + 16 * t) = o; } } while (0)
#define ST_COMPUTE(KS, VS) do { acc[0] *= cdec; acc[1] *= cdec; _Pragma("unroll") for (int ks = 0; ks < 4; ++ks) { const bf16x8 bv = scale8(VS[ks], dec[ks]); \
        _Pragma("unroll") for (int t = 0; t < 2; ++t) acc[t] = __builtin_amdgcn_mfma_f32_16x16x32_bf16(KS[ks][t], bv, acc[t], 0, 0, 0); } } while (0)
    ST_LOAD(ka, va, ST_MC(0));
    for (int s2 = 0; s2 < NCH; s2 += 2) {
        ST_STORE(ST_MC(s2));
        { const int sn = s2 + 1 < NCH - 1 ? s2 + 1 : NCH - 2; ST_LOAD(kb2, vb2, ST_MC(sn)); }
        ST_COMPUTE(ka, va);
        ST_STORE(ST_MC(s2 + 1));
        if (s2 + 1 == NCH - 1) break;
        { const int sn = s2 + 2 < NCH - 1 ? s2 + 2 : NCH - 2; ST_LOAD(ka, va, ST_MC(sn)); }
        ST_COMPUTE(kb2, vb2);
    }
#undef ST_MC
#undef ST_LOAD
#undef ST_STORE
#undef ST_COMPUTE
}

__device__ __forceinline__ void lru_item(const Args& A, Frame& F, int l, int it) {
    refresh(F);
    const int blk = it & 15, dir = (it >> 4) & 1, b = it >> 5;
    const int tid = F.tid, lane = F.lane, fr = lane & 15, fq = lane >> 4, w = F.wave;
    LAS float* us = (LAS float*)F.lds;
    LAS float* as = us + 128 * 64;
    LAS bf16_t* ub = (LAS bf16_t*)(F.lds + 65536);
    LAS bf16_t* wgs = (LAS bf16_t*)(F.lds + 65536 + 18432);
    LAS float* segA = (LAS float*)(F.lds + 65536 + 2 * 18432);
    LAS float* segB = segA + 512;
    LAS float* hcar = segA + 2048;
    __syncthreads();
    {
        const float* gw = GIN(16) + ((size_t)(l * 2 + dir) * 2) * 16 * 64 * 64;
        for (int e = tid; e < 2 * 64 * 64; e += NTHREADS) {
            const int g = e >> 12, k = (e >> 6) & 63, j = e & 63;
            wgs[(g * 64 + j) * 72 + k] = f2bf(gw[((size_t)(g * 16 + blk) * 64 + k) * 64 + j]);
        }
        if (tid < 128) hcar[tid] = 0.f;
    }
    float bgr[4], bgi[4], spl[4];
#pragma unroll
    for (int nt = 0; nt < 4; ++nt) {
        const int ch = blk * 64 + 16 * nt + fr;
        bgr[nt] = GIN(17)[((size_t)(l * 2 + dir) * 2 + 0) * D + ch];
        bgi[nt] = GIN(17)[((size_t)(l * 2 + dir) * 2 + 1) * D + ch];
        spl[nt] = -8.f * 1.4426950408889634f * softplusf_(-GIN(18)[(size_t)(l * 2 + dir) * D + ch]);
    }
    const int c4 = (tid & 15) * 4, chg = blk * 64 + c4;
    f32x4 cw[4];
#pragma unroll
    for (int j = 0; j < 4; ++j) cw[j] = *(const f32x4*)(GIN(14) + (size_t)(l * 4 + j) * D + chg);
    const f32x4 cb = *(const f32x4*)(GIN(15) + (size_t)l * D + chg);
    const bf16_t* lx = WSB(WS_LX) + (size_t)b * TB * D + chg;
    bf16_t* hout = (dir ? WSB(WS_HB) : WSB(WS_HF)) + (size_t)b * TB * D + blk * 64;
    __syncthreads();
    const int g4 = tid >> 4;
    u32x2 xr[7];
    {
        const int pb0 = dir == 0 ? 0 : 255;
        const int pmin = dir == 0 ? pb0 + 4 * g4 : pb0 - 4 * g4 - 3;
#pragma unroll
        for (int e = 0; e < 7; ++e) { const int q = pmin - 2 + e; const int qc = q < 0 ? 0 : (q >= CTXL ? CTXL - 1 : q); xr[e] = *(const u32x2*)(lx + (size_t)qc * D); }
    }
    for (int sc = 0; sc < NCH; ++sc) {
        const int lo = sc < 2 ? 0 : CTXL, hi = sc < 2 ? CTXL : TB;
        const int pbase = dir == 0 ? 128 * sc : (sc < 2 ? 255 - 128 * sc : 2303 - 128 * (sc - 2));
        {
            const int pmin = dir == 0 ? pbase + 4 * g4 : pbase - 4 * g4 - 3;
            f32x4 xw[7];
#pragma unroll
            for (int e = 0; e < 7; ++e) {
                const int q = pmin - 2 + e;
                const float msk = (q >= lo && q < hi) ? 1.f : 0.f;
                xw[e][0] = bflo(xr[e].x) * msk; xw[e][1] = bfhi(xr[e].x) * msk; xw[e][2] = bflo(xr[e].y) * msk; xw[e][3] = bfhi(xr[e].y) * msk;
            }
#pragma unroll
            for (int m = 0; m < 4; ++m) {
                const f32x4 a = cb + cw[0] * xw[m] + cw[1] * xw[m + 1] + cw[2] * xw[m + 2] + cw[3] * xw[m + 3];
                const int si = dir == 0 ? 4 * g4 + m : 4 * g4 + 3 - m;
                *(LAS f32x4*)(us + si * 64 + c4) = a;
                u32x2 o; o.x = pk2(a[0], a[1]); o.y = pk2(a[2], a[3]);
                *(LAS u32x2*)(ub + si * 72 + c4) = o;
            }
        }
        {
            const int sn = sc + 1 < NCH ? sc + 1 : sc;
            const int lon = sn < 2 ? 0 : CTXL, hin = sn < 2 ? CTXL : TB;
            const int pbn = dir == 0 ? 128 * sn : (sn < 2 ? 255 - 128 * sn : 2303 - 128 * (sn - 2));
            const int pminn = dir == 0 ? pbn + 4 * g4 : pbn - 4 * g4 - 3;
#pragma unroll
            for (int e = 0; e < 7; ++e) { const int q = pminn - 2 + e; const int qc = q < lon ? lon : (q >= hin ? hin - 1 : q); xr[e] = *(const u32x2*)(lx + (size_t)qc * D); }
        }
        __builtin_amdgcn_fence(__ATOMIC_RELEASE, "workgroup"); __builtin_amdgcn_wave_barrier(); __builtin_amdgcn_fence(__ATOMIC_ACQUIRE, "workgroup");
        {
            bf16x8 af[2];
#pragma unroll
            for (int ks = 0; ks < 2; ++ks) af[ks] = *(const LAS bf16x8*)(ub + (16 * w + fr) * 72 + 32 * ks + 8 * fq);
            f32x4 gacc[8];
#pragma unroll
            for (int nt = 0; nt < 8; ++nt) {
                gacc[nt] = (f32x4){0.f, 0.f, 0.f, 0.f};
#pragma unroll
                for (int ks = 0; ks < 2; ++ks) {
                    const bf16x8 bfm = *(const LAS bf16x8*)(wgs + (16 * nt + fr) * 72 + 32 * ks + 8 * fq);
                    gacc[nt] = __builtin_amdgcn_mfma_f32_16x16x32_bf16(af[ks], bfm, gacc[nt], 0, 0, 0);
                }
            }
#pragma unroll
            for (int nt = 0; nt < 4; ++nt)
#pragma unroll
                for (int r = 0; r < 4; ++r) {
                    const int si = 16 * w + 4 * fq + r, ch = 16 * nt + fr;
                    const float d0 = 1.f + __builtin_amdgcn_exp2f(fminf((gacc[nt][r] + bgr[nt]) * -1.4426950408889634f, 60.f));
                    const float d1 = 1.f + __builtin_amdgcn_exp2f(fminf((gacc[nt + 4][r] + bgi[nt]) * -1.4426950408889634f, 60.f));
                    const float rr = frcp(d0 * d1);
                    const float rg = rr * d1, ig = rr * d0;
                    const float av = __builtin_amdgcn_exp2f(rg * spl[nt]);
                    const float mult = __builtin_amdgcn_sqrtf(fmaxf(1.f - av * av, 0.f));
                    const float uu = us[si * 64 + ch];
                    as[si * 64 + ch] = av;
                    us[si * 64 + ch] = mult * ig * uu;
                }
        }
        __builtin_amdgcn_fence(__ATOMIC_RELEASE, "workgroup"); __builtin_amdgcn_wave_barrier(); __builtin_amdgcn_fence(__ATOMIC_ACQUIRE, "workgroup");
        {
            const int ch = tid & 63, seg = tid >> 6;
            float A = 1.f, Bv = 0.f;
#pragma unroll
            for (int i = 0; i < 16; ++i) { const int si = 16 * seg + i; const float a = as[si * 64 + ch], bb = us[si * 64 + ch]; A *= a; Bv = a * Bv + bb; }
            LAS float* sA = segA + (sc & 1) * 1024; LAS float* sB = segB + (sc & 1) * 1024;
            sA[seg * 64 + ch] = A; sB[seg * 64 + ch] = Bv;
            __syncthreads();
            float hv = hcar[(sc & 1) * 64 + ch];
            for (int s = 0; s < seg; ++s) hv = sA[s * 64 + ch] * hv + sB[s * 64 + ch];
#pragma unroll
            for (int i = 0; i < 16; ++i) {
                const int si = 16 * seg + i; const float a = as[si * 64 + ch], bb = us[si * 64 + ch];
                hv = a * hv + bb;
                const int p = dir == 0 ? pbase + si : pbase - si;
                hout[(size_t)p * D + ch] = f2bf(hv);
            }
            if (seg == 7) hcar[((sc + 1) & 1) * 64 + ch] = hv;
            __builtin_amdgcn_fence(__ATOMIC_RELEASE, "workgroup"); __builtin_amdgcn_wave_barrier(); __builtin_amdgcn_fence(__ATOMIC_ACQUIRE, "workgroup");
        }
    }
    __syncthreads();
}

struct RetPre { u32x4 k[2], sf[2], sb[2], vt[4]; };
__device__ __forceinline__ void ret_prefetch(const Frame& F, int it, int nchu, RetPre& P) {
    const int bh = it / nchu, mc = it - bh * nchu + (NCH - nchu), h = bh & 7, b = bh >> 3;
    const int tid = F.tid;
    const size_t rowbase = (size_t)b * TB + 128 * mc;
#pragma unroll
    for (int i = 0; i < 2; ++i) {
        const int u = tid + i * NTHREADS, r = u >> 3, c8 = (u & 7) * 8;
        P.k[i] = *(const u32x4*)(WSB(WS_KN) + (rowbase + r) * 512 + h * 64 + c8);
        P.sf[i] = *(const u32x4*)(WSB(WS_ST) + ((((size_t)(b * NH + h) * 2 + 0) * NCH + mc) * DV + r) * DK + c8);
        P.sb[i] = *(const u32x4*)(WSB(WS_ST) + ((((size_t)(b * NH + h) * 2 + 1) * NCH + mc) * DV + r) * DK + c8);
    }
#pragma unroll
    for (int i = 0; i < 4; ++i) {
        const int u = tid + i * NTHREADS, r = u >> 4, c8 = (u & 15) * 8;
        P.vt[i] = *(const u32x4*)(WSB(WS_VT) + ((size_t)(b * NH + h) * DV + r) * TB + 128 * mc + c8);
    }
}
__device__ __forceinline__ void ret_out_phase(const Args& A, Frame& F, int l, bool lastl, bf16_t* ARET, bf16_t* ALRU) {
    refresh(F);
    const int tid = F.tid, lane = F.lane, fr = lane & 15, fq = lane >> 4, w = F.wave;
    LAS bf16_t* ks_ = (LAS bf16_t*)F.lds;
    LAS bf16_t* vts = (LAS bf16_t*)(F.lds + 18432);
    LAS bf16_t* sfs = (LAS bf16_t*)(F.lds + 18432 + 34816);
    LAS bf16_t* sbs = (LAS bf16_t*)(F.lds + 2 * 18432 + 34816);
    LAS bf16_t* os = (LAS bf16_t*)(F.lds + 3 * 18432 + 34816);
    const int NCHU = lastl ? NCH - 2 : NCH;
    const int NIT = NB * NH * NCHU;
    const int nmy = (NIT - F.bid + F.G - 1) / F.G;
    RetPre P;
    ret_prefetch(F, F.bid, NCHU, P);
    for (int jx = 0; jx < nmy; ++jx) {
        const int it = F.bid + jx * F.G, itn = (jx + 1 < nmy) ? it + F.G : it;
        const int bh = it / NCHU, mc = it - bh * NCHU + (NCH - NCHU), h = bh & 7, b = bh >> 3;
        const size_t rowbase = (size_t)b * TB + 128 * mc;
        __syncthreads();
#pragma unroll
        for (int i = 0; i < 2; ++i) {
            const int u = tid + i * NTHREADS, r = u >> 3, c8 = (u & 7) * 8;
            *(LAS u32x4*)(ks_ + r * 72 + c8) = P.k[i]; *(LAS u32x4*)(sfs + r * 72 + c8) = P.sf[i]; *(LAS u32x4*)(sbs + r * 72 + c8) = P.sb[i];
        }
#pragma unroll
        for (int i = 0; i < 4; ++i) { const int u = tid + i * NTHREADS, r = u >> 4, c8 = (u & 15) * 8; *(LAS u32x4*)(vts + r * 136 + c8) = P.vt[i]; }
        bf16x8 qf[2];
#pragma unroll
        for (int ks = 0; ks < 2; ++ks) qf[ks] = *(const bf16x8*)(WSB(WS_Q) + (rowbase + 16 * w + fr) * 512 + h * 64 + 32 * ks + 8 * fq);
        __syncthreads();
        ret_prefetch(F, itn, NCHU, P);
        const float l2f = log2_gamma(A, F, l, 0, h), l2b = log2_gamma(A, F, l, 1, h);
        bf16x8 pa[4];
        {
            const int i_loc = 16 * w + fr;
#pragma unroll
            for (int jp = 0; jp < 4; ++jp) {
                f32x4 c0 = (f32x4){0.f, 0.f, 0.f, 0.f}, c1 = c0;
#pragma unroll
                for (int ks = 0; ks < 2; ++ks) {
                    const bf16x8 k0 = *(const LAS bf16x8*)(ks_ + (32 * jp + fr) * 72 + 32 * ks + 8 * fq);
                    const bf16x8 k1 = *(const LAS bf16x8*)(ks_ + (32 * jp + 16 + fr) * 72 + 32 * ks + 8 * fq);
                    c0 = __builtin_amdgcn_mfma_f32_16x16x32_bf16(k0, qf[ks], c0, 0, 0, 0);
                    c1 = __builtin_amdgcn_mfma_f32_16x16x32_bf16(k1, qf[ks], c1, 0, 0, 0);
                }
                float v[8];
#pragma unroll
                for (int r = 0; r < 4; ++r) {
                    const int j0 = 32 * jp + 4 * fq + r, j1 = j0 + 16;
                    const int d0 = i_loc - j0, d1 = i_loc - j1;
                    v[r] = c0[r] * (d0 >= 0 ? exp2f((float)d0 * l2f) : exp2f((float)(-d0) * l2b));
                    v[4 + r] = c1[r] * (d1 >= 0 ? exp2f((float)d1 * l2f) : exp2f((float)(-d1) * l2b));
                }
                u32x4 pv; pv[0] = pk2(v[0], v[1]); pv[1] = pk2(v[2], v[3]); pv[2] = pk2(v[4], v[5]); pv[3] = pk2(v[6], v[7]);
                pa[jp] = __builtin_bit_cast(bf16x8, pv);
            }
        }
        bf16x8 qF[2], qB[2];
        {
            const int il = 16 * w + fr;
            const float sF = exp2f((float)(il + 1) * l2f), sB = exp2f((float)(128 - il) * l2b);
#pragma unroll
            for (int ks = 0; ks < 2; ++ks) { qF[ks] = scale1(qf[ks], sF); qB[ks] = scale1(qf[ks], sB); }
        }
        f32x4 O[8];
#pragma unroll
        for (int dvt = 0; dvt < 8; ++dvt) {
            f32x4 o = (f32x4){0.f, 0.f, 0.f, 0.f};
#pragma unroll
            for (int jp = 0; jp < 4; ++jp) {
                const u32x2 lo = *(const LAS u32x2*)(vts + (16 * dvt + fr) * 136 + 32 * jp + 4 * fq);
                const u32x2 hi = *(const LAS u32x2*)(vts + (16 * dvt + fr) * 136 + 32 * jp + 16 + 4 * fq);
                u32x4 bv; bv[0] = lo.x; bv[1] = lo.y; bv[2] = hi.x; bv[3] = hi.y;
                o = __builtin_amdgcn_mfma_f32_16x16x32_bf16(pa[jp], __builtin_bit_cast(bf16x8, bv), o, 0, 0, 0);
            }
#pragma unroll
            for (int ks = 0; ks < 2; ++ks) {
                const bf16x8 sf = *(const LAS bf16x8*)(sfs + (16 * dvt + fr) * 72 + 32 * ks + 8 * fq);
                const bf16x8 sb = *(const LAS bf16x8*)(sbs + (16 * dvt + fr) * 72 + 32 * ks + 8 * fq);
                o = __builtin_amdgcn_mfma_f32_16x16x32_bf16(qF[ks], sf, o, 0, 0, 0);
                o = __builtin_amdgcn_mfma_f32_16x16x32_bf16(qB[ks], sb, o, 0, 0, 0);
            }
            O[dvt] = o;
            __builtin_amdgcn_sched_barrier(0);
        }
#pragma unroll
        for (int r = 0; r < 4; ++r) {
            float sm = 0.f;
#pragma unroll
            for (int dvt = 0; dvt < 8; ++dvt) sm += O[dvt][r];
            const float mu = sum16(sm) * (1.f / DV);
            float q2 = 0.f;
#pragma unroll
            for (int dvt = 0; dvt < 8; ++dvt) { const float dd = O[dvt][r] - mu; q2 += dd * dd; }
            const float rstd = rsqrtf(sum16(q2) * (1.f / DV) + EPS);
#pragma unroll
            for (int dvt = 0; dvt < 8; ++dvt) os[(16 * w + 4 * fq + r) * 136 + 16 * dvt + fr] = f2bf((O[dvt][r] - mu) * rstd);
        }
        __builtin_amdgcn_fence(__ATOMIC_RELEASE, "workgroup"); __builtin_amdgcn_wave_barrier(); __builtin_amdgcn_fence(__ATOMIC_ACQUIRE, "workgroup");
        {
            const int rr = 16 * w + (lane >> 2), cc = (lane & 3) * 32;
            const size_t go = (rowbase + rr) * D + 128 * h + cc;
#pragma unroll
            for (int i = 0; i < 4; ++i) {
                const u32x4 ov = *(const LAS u32x4*)(os + rr * 136 + cc + 8 * i);
                const u32x4 gv = *(const u32x4*)(WSB(WS_SG) + go + 8 * i);
                u32x4 rv;
#pragma unroll
                for (int e = 0; e < 4; ++e) rv[e] = pk2(bflo(ov[e]) * bflo(gv[e]), bfhi(ov[e]) * bfhi(gv[e]));
                *(u32x4*)(ARET + go + 8 * i) = rv;
            }
        }
#pragma unroll 2
        for (int i = 0; i < 4; ++i) {
            const int u = tid + i * NTHREADS, r = u >> 4, c8 = (u & 15) * 8;
            const size_t o = (rowbase + r) * D + 128 * h + c8;
            const u32x4 hf = *(const u32x4*)(WSB(WS_HF) + o), hb = *(const u32x4*)(WSB(WS_HB) + o), gg = *(const u32x4*)(WSB(WS_GG) + o);
            u32x4 ov;
#pragma unroll
            for (int e = 0; e < 4; ++e) ov[e] = pk2((bflo(hf[e]) + bflo(hb[e])) * bflo(gg[e]), (bfhi(hf[e]) + bfhi(hb[e])) * bfhi(gg[e]));
            *(u32x4*)(ALRU + o) = ov;
        }
    }
    __syncthreads();
}

__global__ void __launch_bounds__(NTHREADS) mega(Args args) {
    extern __shared__ __attribute__((aligned(16))) unsigned char lds_raw[];
    cg::grid_group grid = cg::this_grid();
    Frame F;
    F.lds = (LAS unsigned char*)lds_raw;
    F.tid = threadIdx.x; F.lane = F.tid & 63; F.wave = __builtin_amdgcn_readfirstlane(F.tid >> 6);
    F.G = gridDim.x; F.bid = blockIdx.x;
    volatile LAS unsigned* bst = (volatile LAS unsigned*)(F.lds + LDS_WORK);
    if (F.tid < 4) bst[F.tid] = 0u;
    __syncthreads();
    XcdBarrier xbar = xcd_barrier_post((unsigned*)(args.ws + WS_BAR), bst);
    F.ws = args.ws;
    bf16_t* const ARET = WSB(WS_AN);
    bf16_t* const ALRU = WSB(WS_LX);
    bf16_t* const MB = WSB(WS_SG);

    const int lo = args.ph_lo, hi = args.ph_hi;
    constexpr int NPH = 2 + 12 * NL;
    for (int ph = lo; ph < hi; ++ph) {
        { int z = 0; unsigned long long w = (unsigned long long)args.ws; int bb = (int)blockIdx.x, gg = (int)gridDim.x; asm volatile("" : "+s"(z), "+s"(w), "+s"(bb), "+s"(gg)); F.z = z; F.ws = (unsigned char*)(GAS unsigned char*)w; F.bid = bb; F.G = gg; }
        if (ph == 0) { mods_phase(args, F); init_phase(args, F); convert_layer(args, F, 0); }
        else if (ph == NPH - 1) { final_phase(args, F); }
        else {
            const int l = (ph - 1) / 12, k = (ph - 1) - 12 * l;
            const bool lastl = (l == NL - 1);
            for (int rep = 0; rep < ((PROBE_K >= 0 && k == PROBE_K) ? PROBE_N : 1); ++rep) {
            if (rep > 0) __syncthreads();
            if (k == 0 || k == 3 || k == 9) {
                if (k == 0 && l > 0) convert_layer(args, F, l);
                norm_phase(args, F, l, k == 0 ? 0 : (k == 3 ? 1 : 2), lastl && k == 9, F.G == 256 && !(l == 0 && k == 0) && !(lastl && k == 9));
            } else if (k == 1 || k == 10) {
                const int lat = (lastl && k == 10) ? 1 : 0;
                bf16_t* Bw = k == 1 ? WSB(WS_WGU1) : WSB(WS_WGU2);
                pg8::Gemm g{WSB(WS_AN), WSB(WS_AN), Bw, Bw, D}; pg8::Sched S; S.init(lat ? 64 : 72, 22, F.G, F.bid, 0, lat, 0, D);
                EpiSwiglu E{F.ws}; pg8::build_units(F.lds, S); pg8::gemm_phase(F.lds, g, E);
            } else if (k == 2 || k == 8 || k == 11) {
                const int lat = (lastl && k != 2) ? 1 : 0;
                if (k == 8 && !lat && F.G == 256) {
                    const int row = F.bid * 8 + F.wave;
                    f32x4 v[4];
#pragma unroll
                    for (int j = 0; j < 4; ++j) v[j] = (f32x4){0.f, 0.f, 0.f, 0.f};
#pragma unroll
                    for (int sp = 0; sp < 8; ++sp) {
                        const u32x2* pr = (const u32x2*)(WSB(WS_PART2) + ((size_t)sp * 2048 + row) * D) + F.lane;
#pragma unroll
                        for (int j = 0; j < 4; ++j) { const u32x2 pv = pr[64 * j]; v[j][0] += bflo(pv.x); v[j][1] += bfhi(pv.x); v[j][2] += bflo(pv.y); v[j][3] += bfhi(pv.y); }
                    }
                    u32x2* o8 = (u32x2*)(MB + (size_t)(16384 + row) * D) + F.lane;
#pragma unroll
                    for (int j = 0; j < 4; ++j) { u32x2 o; o.x = pk2(v[j][0], v[j][1]); o.y = pk2(v[j][2], v[j][3]); o8[64 * j] = o; }
                    { XcdBarrier xb = xbar; unsigned* bp = xb.bar; unsigned bx = xb.x; asm volatile("" : "+s"(bp), "+s"(bx)); xb.bar = (unsigned*)(GAS unsigned*)(unsigned long long)bp; xb.x = bx; xcd_barrier(xb); }
                }
                bf16_t* Aop = k == 8 ? MB : WSB(WS_H);
                bf16_t* Bw = k == 2 ? WSB(WS_WD1) : (k == 8 ? WSB(WS_WOUT) : WSB(WS_WD2));
                pg8::Gemm g{Aop, Aop, Bw, Bw, k == 8 ? D : FH}; pg8::Sched S; S.init(lat ? 64 : 72, 4, F.G, F.bid, 0, lat, (!lat && F.G == 256) ? 1 : 0, k == 8 ? D : FH);
                EpiRes E{F.ws, l, k == 2 ? 2 : (k == 8 ? 5 : 8), k == 8 ? 1.0f : 0.5f}; pg8::build_units(F.lds, S); pg8::gemm_phase(F.lds, g, E);
            } else if (k == 4) {
                pg8::Gemm g{WSB(WS_AN), WSB(WS_AN), WSB(WS_WIN), WSB(WS_WIN), D}; pg8::Sched S; S.init(72, 28, F.G, F.bid, 0, 0, 0, D);
                EpiWin E{F.ws}; pg8::build_units(F.lds, S); pg8::gemm_phase(F.lds, g, E);
            } else if (k == 5) {
                for (int it = F.bid; it < 512; it += F.G) { if (it < 256) lru_item(args, F, l, it); else ret_state_item(args, F, l, it - 256); }
            } else if (k == 6) {
                ret_out_phase(args, F, l, lastl, ARET, ALRU);
            } else {
                const int lat = lastl ? 1 : 0;
                pg8::Gemm g{ARET, ALRU, WSB(WS_WRO), WSB(WS_WLO), D}; pg8::Sched S; S.init(lat ? 64 : 72, 4, F.G, F.bid, 1, lat, (!lat && F.G == 256) ? 2 : 0, D);
                EpiMerge E{F.ws}; pg8::build_units(F.lds, S); pg8::gemm_phase(F.lds, g, E);
            }
            }
        }
        if (ph + 1 < hi) { if (args.coop == 0x7fffffff) grid.sync();
            { XcdBarrier xb = xbar; unsigned* bp = xb.bar; unsigned bx = xb.x; asm volatile("" : "+s"(bp), "+s"(bx)); xb.bar = (unsigned*)(GAS unsigned*)(unsigned long long)bp; xb.x = bx; xcd_barrier(xb); } }
    }
}

constexpr int N_PHASES = 2 + 12 * NL;

extern "C" void kernel_launch(void* const* d_in, const int* in_sizes, int n_in, void* d_out, int out_size, void* d_ws, size_t ws_size, hipStream_t stream) {
    static int grid = 0;
    if (grid == 0) {
        if (n_in != 22 || ws_size < WS_END) { fprintf(stderr, "kernel_launch: need 22 inputs and %zu bytes of workspace (got %d, %zu)\n", (size_t)WS_END, n_in, ws_size); grid = -1; return; }
        int dev = 0, cus = 0, per_cu = 0;
        hipGetDevice(&dev);
        hipDeviceGetAttribute(&cus, hipDeviceAttributeMultiprocessorCount, dev);
        if (hipFuncSetAttribute((const void*)mega, hipFuncAttributeMaxDynamicSharedMemorySize, LDS_BYTES) != hipSuccess) { fprintf(stderr, "kernel_launch: hipFuncSetAttribute failed\n"); grid = -1; return; }
        if (hipOccupancyMaxActiveBlocksPerMultiprocessor(&per_cu, (const void*)mega, NTHREADS, LDS_BYTES) != hipSuccess || per_cu < 1) { fprintf(stderr, "kernel_launch: occupancy query says %d\n", per_cu); per_cu = 1; }
        (void)hipGetLastError();
        grid = cus * per_cu;
        if (grid > 256) grid = 256;
    }
    if (grid < 0) return;
    if (hipMemsetAsync(d_ws, 0, 16384, stream) != hipSuccess) { fprintf(stderr, "kernel_launch: memset of barrier words failed\n"); return; }
    Args a{};
    for (int i = 0; i < 22; ++i) a.in[i] = (const float*)d_in[i];
    a.out = (float*)d_out; a.ws = (unsigned char*)d_ws;
#if MK_MULTI
    for (int p = 0; p < N_PHASES; ++p) {
        a.ph_lo = p; a.ph_hi = p + 1; a.coop = 0;
        hipLaunchKernelGGL(mega, dim3(grid), dim3(NTHREADS), LDS_BYTES, stream, a);
    }
#else
    a.ph_lo = 0; a.ph_hi = N_PHASES; a.coop = 1;
    void* kargs[] = {&a};
    hipError_t e = hipLaunchCooperativeKernel((const void*)mega, dim3(grid), dim3(NTHREADS), kargs, LDS_BYTES, stream);
    if (e != hipSuccess) fprintf(stderr, "cooperative launch failed: %s (grid %d)\n", hipGetErrorString(e), grid);
#endif
}
```
